# Optimizing an MI355X kernel written in HIP

```python
import jax
import jax.numpy as jnp
from jax import lax
import numpy as np

D_MODEL = 1024
BATCH = 2
SEQ = 8192
DEPTH = 2

CTX_LEN = 256
GRID_W = 64
BLOCK = 128
WINDOW = 128
ROPE_BASE = 10000.0
EPS = 1e-6
NEG_INF = -1e30

H_A = 8
HKV_A = 2
G_A = H_A // HKV_A
HD_A = 64
SCALE_A = HD_A ** -0.5

H_B = 8
Q_LORA = 384
KV_LORA = 256
NOPE_B = 64
ROPE_B = 32
V_B = 64
SCALE_B = (NOPE_B + ROPE_B) ** -0.5

W_C = 512
CONV_K = 3

W_BRANCH = 512

IN_SIZES = (H_A * HD_A, HKV_A * HD_A, HKV_A * HD_A, W_BRANCH,
            Q_LORA, KV_LORA, ROPE_B, W_BRANCH,
            W_C, W_C, W_C, W_BRANCH,
            D_MODEL, D_MODEL, D_MODEL)
D_IN = sum(IN_SIZES)

kernel_name = "hybrid_gated_branch_diffusion_trunk"


def rms_norm(x, g):
    xf = x.astype(jnp.float32)
    y = xf * lax.rsqrt(jnp.mean(xf * xf, axis=-1, keepdims=True) + EPS)
    return (y * g.astype(jnp.float32)).astype(x.dtype)


def axial_rope_angles(rows, rot_dim):
    row = jnp.repeat(jnp.arange(rows, dtype=jnp.float32), GRID_W)
    col = jnp.tile(jnp.arange(GRID_W, dtype=jnp.float32), rows)
    axis_dim = rot_dim // 2
    inv = ROPE_BASE ** (-jnp.arange(0, axis_dim, 2, dtype=jnp.float32) / axis_dim)
    ang = jnp.concatenate([row[:, None] * inv, col[:, None] * inv], axis=-1)
    return jnp.cos(ang), jnp.sin(ang)


def apply_rope(x, cos, sin):
    xf = x.astype(jnp.float32)
    x1, x2 = jnp.split(xf, 2, axis=-1)
    c = cos[None, :, None, :]
    s = sin[None, :, None, :]
    return jnp.concatenate([x1 * c - x2 * s, x2 * c + x1 * s], axis=-1).astype(x.dtype)


def in_proj(h, w_in):
    splits = np.cumsum(IN_SIZES)[:-1].tolist()
    return jnp.split(h @ w_in, splits, axis=-1)


def window_attn_latent(q, k, v, k_ctx, v_ctx, sink):
    B, S = q.shape[:2]
    nb = S // BLOCK
    qb = q.reshape(B, nb, BLOCK, HKV_A, G_A, HD_A)
    pad = ((0, 0), (BLOCK, BLOCK), (0, 0), (0, 0))
    kp = jnp.pad(k, pad).reshape(B, nb + 2, BLOCK, HKV_A, HD_A)
    vp = jnp.pad(v, pad).reshape(B, nb + 2, BLOCK, HKV_A, HD_A)
    kw = jnp.concatenate([kp[:, :-2], kp[:, 1:-1], kp[:, 2:]], axis=2)
    vw = jnp.concatenate([vp[:, :-2], vp[:, 1:-1], vp[:, 2:]], axis=2)
    s_loc = jnp.einsum('bnqhgd,bnkhd->bnhgqk', qb, kw).astype(jnp.float32) * SCALE_A
    qi = jnp.arange(BLOCK)[:, None] + BLOCK
    kj = jnp.arange(3 * BLOCK)[None, :]
    band = jnp.abs(kj - qi) <= WINDOW
    kabs = jnp.arange(nb)[:, None] * BLOCK + jnp.arange(3 * BLOCK)[None, :] - BLOCK
    valid = (kabs >= 0) & (kabs < S)
    mask = band[None, :, :] & valid[:, None, :]
    s_loc = jnp.where(mask[None, :, None, None], s_loc, NEG_INF)
    s_ctx = jnp.einsum('bnqhgd,blhd->bnhgql', qb, k_ctx).astype(jnp.float32) * SCALE_A
    s_sink = jnp.broadcast_to(sink.astype(jnp.float32).reshape(1, 1, HKV_A, G_A, 1, 1),
                              s_loc.shape[:-1] + (1,))
    p = jax.nn.softmax(jnp.concatenate([s_loc, s_ctx, s_sink], axis=-1), axis=-1)
    p_loc = p[..., :3 * BLOCK].astype(v.dtype)
    p_ctx = p[..., 3 * BLOCK:3 * BLOCK + k_ctx.shape[1]].astype(v.dtype)
    o = (jnp.einsum('bnhgqk,bnkhd->bnqhgd', p_loc, vw)
         + jnp.einsum('bnhgql,blhd->bnqhgd', p_ctx, v_ctx))
    return o.reshape(B, S, H_A * HD_A)


def ctx_gqa_attn(q, k, v, sink):
    B, L = q.shape[:2]
    qg = q.reshape(B, L, HKV_A, G_A, HD_A)
    s = jnp.einsum('blhgd,bmhd->bhglm', qg, k).astype(jnp.float32) * SCALE_A
    sk = jnp.broadcast_to(sink.astype(jnp.float32).reshape(1, HKV_A, G_A, 1, 1), (B, HKV_A, G_A, L, 1))
    p = jax.nn.softmax(jnp.concatenate([s, sk], axis=-1), axis=-1)[..., :L]
    o = jnp.einsum('bhglm,bmhd->blhgd', p.astype(v.dtype), v)
    return o.reshape(B, L, H_A * HD_A)


def mla_project(q_lat, kv_lat, g_qa, w_qb, g_kva, w_kvb):
    B, T = q_lat.shape[:2]
    q = (rms_norm(q_lat, g_qa) @ w_qb).reshape(B, T, H_B, NOPE_B + ROPE_B)
    kv = (rms_norm(kv_lat, g_kva) @ w_kvb).reshape(B, T, H_B, NOPE_B + V_B)
    return q[..., :NOPE_B], q[..., NOPE_B:], kv[..., :NOPE_B], kv[..., NOPE_B:]


def mla_attn_latent(qn, qr, kn, kr, v, kn_c, kr_c, v_c):
    B, S = qn.shape[:2]
    nb = S // BLOCK
    keys_n = jnp.concatenate([kn, kn_c], axis=1)
    keys_r = jnp.concatenate([kr, kr_c], axis=1)
    vals = jnp.concatenate([v, v_c], axis=1)

    def block(qs):
        q_n, q_r = qs
        s = (jnp.einsum('bqhd,bkhd->bhqk', q_n, keys_n)
             + jnp.einsum('bqhd,bkd->bhqk', q_r, keys_r))
        p = jax.nn.softmax(s.astype(jnp.float32) * SCALE_B, axis=-1)
        return jnp.einsum('bhqk,bkhd->bqhd', p.astype(vals.dtype), vals)

    qn_b = qn.reshape(B, nb, BLOCK, H_B, NOPE_B).swapaxes(0, 1)
    qr_b = qr.reshape(B, nb, BLOCK, H_B, ROPE_B).swapaxes(0, 1)
    o = lax.map(block, (qn_b, qr_b))
    return o.swapaxes(0, 1).reshape(B, S, H_B * V_B)


def ctx_mla_attn(qn, qr, kn, kr, v):
    B, L = qn.shape[:2]
    s = jnp.einsum('blhd,bmhd->bhlm', qn, kn) + jnp.einsum('blhd,bmd->bhlm', qr, kr)
    p = jax.nn.softmax(s.astype(jnp.float32) * SCALE_B, axis=-1)
    o = jnp.einsum('bhlm,bmhd->blhd', p.astype(v.dtype), v)
    return o.reshape(B, L, H_B * V_B)


def short_gated_conv(b_gate, c_gate, u, conv_w):
    z = jnp.pad(c_gate * u, ((0, 0), (1, 1), (0, 0)))
    y = conv_w[0] * z[:, :-2] + conv_w[1] * z[:, 1:-1] + conv_w[2] * z[:, 2:]
    return b_gate * y


def merge_branches(ya, yb, yc, za, zb, zc, ga, gb, gc, w_branch, w_o):
    m = (jax.nn.sigmoid(ga) * ((ya * jax.nn.silu(za)) @ w_branch[0])
         + jax.nn.sigmoid(gb) * ((yb * jax.nn.silu(zb)) @ w_branch[1])
         + jax.nn.sigmoid(gc) * ((yc * jax.nn.silu(zc)) @ w_branch[2]))
    return m @ w_o


def mixer_layer(x, ctx, mod_x, mod_c, rope_a, rope_b, g_pre, g_post, w_in, sink,
                g_qa, w_qb, g_kva, w_kvb, conv_w, w_branch, w_o, update_ctx):
    B, S, _ = x.shape
    L = ctx.shape[1]
    shift_x, scale_x, gate_x = [m[:, None, :] for m in jnp.split(mod_x, 3, axis=-1)]
    shift_c, scale_c, gate_c = jnp.split(mod_c, 3, axis=-1)
    hx = rms_norm(x, g_pre) * (1.0 + scale_x) + shift_x
    hc = rms_norm(ctx, g_pre) * (1.0 + scale_c) + shift_c
    (qa_x, ka_x, va_x, za_x, qlb_x, kvlb_x, krb_x, zb_x,
     bc_x, cc_x, uc_x, zc_x, ga_x, gb_x, gc_x) = in_proj(hx, w_in)
    (qa_c, ka_c, va_c, za_c, qlb_c, kvlb_c, krb_c, zb_c,
     bc_c, cc_c, uc_c, zc_c, ga_c, gb_c, gc_c) = in_proj(hc, w_in)

    cos_a, sin_a = rope_a
    qa = apply_rope(qa_x.reshape(B, S, H_A, HD_A), cos_a, sin_a)
    ka = apply_rope(ka_x.reshape(B, S, HKV_A, HD_A), cos_a, sin_a)
    va = va_x.reshape(B, S, HKV_A, HD_A)
    kac = ka_c.reshape(B, L, HKV_A, HD_A)
    vac = va_c.reshape(B, L, HKV_A, HD_A)
    ya_x = window_attn_latent(qa, ka, va, kac, vac, sink)

    cos_b, sin_b = rope_b
    qn_x, qr_x, kn_x, vb_x = mla_project(qlb_x, kvlb_x, g_qa, w_qb, g_kva, w_kvb)
    qr_x = apply_rope(qr_x, cos_b, sin_b)
    kr_x = apply_rope(krb_x[:, :, None, :], cos_b, sin_b)[:, :, 0]
    qn_c, qr_c, kn_c, vb_c = mla_project(qlb_c, kvlb_c, g_qa, w_qb, g_kva, w_kvb)
    yb_x = mla_attn_latent(qn_x, qr_x, kn_x, kr_x, vb_x, kn_c, krb_c, vb_c)

    yc_x = short_gated_conv(bc_x, cc_x, uc_x, conv_w)

    out_x = merge_branches(ya_x, yb_x, yc_x, za_x, zb_x, zc_x, ga_x, gb_x, gc_x, w_branch, w_o)
    x = x + gate_x * rms_norm(out_x, g_post)

    if update_ctx:
        ya_c = ctx_gqa_attn(qa_c.reshape(B, L, H_A, HD_A), kac, vac, sink)
        yb_c = ctx_mla_attn(qn_c, qr_c, kn_c, krb_c, vb_c)
        yc_c = short_gated_conv(bc_c, cc_c, uc_c, conv_w)
        out_c = merge_branches(ya_c, yb_c, yc_c, za_c, zb_c, zc_c, ga_c, gb_c, gc_c, w_branch, w_o)
        ctx = ctx + gate_c * rms_norm(out_c, g_post)
    return x, ctx


def setup_inputs(seed: int = 0) -> dict:
    key = jax.random.key(seed)
    ks = jax.random.split(key, 17)
    f32 = jnp.float32

    def nrm(k, shape, scale):
        return jax.random.normal(k, shape, f32) * scale

    return {
        "x": nrm(ks[0], (BATCH, SEQ, D_MODEL), 1.0),
        "c": nrm(ks[1], (BATCH, D_MODEL), 1.0),
        "ctx": nrm(ks[2], (BATCH, CTX_LEN, D_MODEL), 1.0),
        "c_ctx": nrm(ks[3], (D_MODEL,), 1.0),
        "w_mod": nrm(ks[4], (DEPTH, D_MODEL, 3 * D_MODEL), 0.5 * D_MODEL ** -0.5),
        "b_mod": nrm(ks[5], (DEPTH, 3 * D_MODEL), 0.01),
        "g_pre": 1.0 + nrm(ks[6], (DEPTH, D_MODEL), 0.05),
        "g_post": 1.0 + nrm(ks[7], (DEPTH, D_MODEL), 0.05),
        "w_in": nrm(ks[8], (DEPTH, D_MODEL, D_IN), D_MODEL ** -0.5),
        "sink": nrm(ks[9], (DEPTH, H_A), 1.0),
        "g_qa": 1.0 + nrm(ks[10], (DEPTH, Q_LORA), 0.05),
        "w_qb": nrm(ks[11], (DEPTH, Q_LORA, H_B * (NOPE_B + ROPE_B)), Q_LORA ** -0.5),
        "g_kva": 1.0 + nrm(ks[12], (DEPTH, KV_LORA), 0.05),
        "w_kvb": nrm(ks[13], (DEPTH, KV_LORA, H_B * (NOPE_B + V_B)), KV_LORA ** -0.5),
        "conv_w": nrm(ks[14], (DEPTH, CONV_K, W_C), CONV_K ** -0.5),
        "w_branch": nrm(ks[15], (DEPTH, 3, W_BRANCH, D_MODEL), W_BRANCH ** -0.5),
        "w_o": nrm(ks[16], (DEPTH, D_MODEL, D_MODEL), D_MODEL ** -0.5),
    }


def reference(x, c, ctx, c_ctx, w_mod, b_mod, g_pre, g_post, w_in, sink,
              g_qa, w_qb, g_kva, w_kvb, conv_w, w_branch, w_o):
    rows = x.shape[1] // GRID_W
    rope_a = axial_rope_angles(rows, HD_A)
    rope_b = axial_rope_angles(rows, ROPE_B)
    sc = jax.nn.silu(c)
    scc = jax.nn.silu(c_ctx)
    for i in range(DEPTH):
        mod_x = sc @ w_mod[i] + b_mod[i]
        mod_c = scc @ w_mod[i] + b_mod[i]
        x, ctx = mixer_layer(x, ctx, mod_x, mod_c, rope_a, rope_b, g_pre[i], g_post[i],
                             w_in[i], sink[i], g_qa[i], w_qb[i], g_kva[i], w_kvb[i],
                             conv_w[i], w_branch[i], w_o[i], update_ctx=(i < DEPTH - 1))
    return x
```

```cpp
#include <hip/hip_runtime.h>
#include <hip/hip_cooperative_groups.h>
#include <cstdint>
#include <cstdio>
namespace cg = cooperative_groups;

#define LAS __attribute__((address_space(3)))
typedef unsigned short bf16_t;
typedef short bf16x8 __attribute__((ext_vector_type(8)));
typedef float f32x4 __attribute__((ext_vector_type(4)));
typedef float f32x16 __attribute__((ext_vector_type(16)));
typedef unsigned u32x4 __attribute__((ext_vector_type(4)));
typedef unsigned u32x2 __attribute__((ext_vector_type(2)));
typedef float f32x2_t __attribute__((ext_vector_type(2)));
typedef __bf16 bf16x2_t __attribute__((ext_vector_type(2)));

constexpr int DM = 1024, NBATCH = 2, SEQ = 8192, CTX = 256, RB = SEQ + CTX  , RT = NBATCH * RB, DEPTH = 2;
constexpr int D_IN = 7584, NV = 7680;
constexpr int QLORA = 384, KVLORA = 256;
constexpr float EPS = 1e-6f, NEG = -1e30f, LOG2E = 1.4426950408889634f;
constexpr float QS_A = 0.125f * LOG2E;
constexpr float QS_B = 0.10206207261596577f * LOG2E;
constexpr float L2_10000 = 13.287712379549449f;

constexpr size_t MiB = 1u << 20;
constexpr size_t WS_MOD = 0;
constexpr size_t WS_BAR = 3 * MiB, BAR_BYTES = 16384;
constexpr size_t WS_CTX1 = 1 * MiB;
constexpr size_t WS_W = 4 * MiB, W_STRIDE = 22 * MiB;
constexpr size_t W_IN = 0, W_QB = W_IN + (size_t)NV * DM * 2, W_KVB = W_QB + (size_t)768 * QLORA * 2, W_BR = W_KVB + (size_t)1024 * KVLORA * 2,
                 W_O = W_BR + (size_t)3 * 1024 * 512 * 2, W_END = W_O + (size_t)1024 * 1024 * 2;
static_assert(W_END <= W_STRIDE, "weights");
constexpr size_t WS_HX = WS_W + 2 * W_STRIDE;
constexpr size_t WS_PB = WS_HX + (size_t)RT * DM * 2;
constexpr size_t B_QA = 0, B_KA = B_QA + (size_t)RB * 512 * 2, B_VAT = B_KA + (size_t)RB * 128 * 2, B_QLAT = B_VAT + (size_t)RB * 128 * 2,
                 B_KVLAT = B_QLAT + (size_t)RB * 384 * 2, B_QB = B_KVLAT + (size_t)RB * 256 * 2, B_KB = B_QB + (size_t)RB * 768 * 2,
                 B_VBT = B_KB + (size_t)RB * 768 * 2, B_YA = B_VBT + (size_t)RB * 512 * 2, B_YB = B_YA + (size_t)RB * 512 * 2,
                 B_PC = B_YB + (size_t)RB * 512 * 2, B_ZC = B_PC + (size_t)RB * 512 * 2, B_G = B_ZC + (size_t)RB * 512 * 2,
                 B_END = B_G + (size_t)RB * 3072 * 2;
constexpr size_t B_OUT = B_END;
constexpr size_t B_M = B_QB;
static_assert(B_M + (size_t)RB * 1024 * 2 <= B_VBT, "overlays");
constexpr size_t WS_END = WS_PB + B_OUT + (size_t)RB * 1024 * 2;
static_assert(WS_END <= 256 * MiB, "workspace");

constexpr int LDS_BYTES = 147456 + 256, LDS_MISC = 147456;
#ifndef PH_MASK
#define PH_MASK 0xFFFF
#endif
#ifndef PROBE_MLA2
#define PROBE_MLA2 0
#endif
#ifndef PROBE_INPROJ2
#define PROBE_INPROJ2 0
#endif
#ifndef PROBE_SYNC2
#define PROBE_SYNC2 0
#endif

__device__ __forceinline__ unsigned pk2(float lo, float hi) { f32x2_t v = {lo, hi}; bf16x2_t b = __builtin_convertvector(v, bf16x2_t); return __builtin_bit_cast(unsigned, b); }
__device__ __forceinline__ float bflo(unsigned w) { return __uint_as_float(w << 16); }
__device__ __forceinline__ float bfhi(unsigned w) { return __uint_as_float(w & 0xffff0000u); }
__device__ __forceinline__ float fexp2(float x) { return __builtin_amdgcn_exp2f(x); }
__device__ __forceinline__ float sigmoidf_(float x) { return __builtin_amdgcn_rcpf(1.0f + fexp2(-x * LOG2E)); }
__device__ __forceinline__ float siluf_(float x) { return x * sigmoidf_(x); }
__device__ __forceinline__ u32x4 pack8(f32x4 a, f32x4 b) { u32x4 w; w.x = pk2(a[0], a[1]); w.y = pk2(a[2], a[3]); w.z = pk2(b[0], b[1]); w.w = pk2(b[2], b[3]); return w; }
__device__ __forceinline__ int tid_from_wave(int wave_s) { int t; asm volatile("v_mbcnt_lo_u32_b32 %0, -1, 0\n\tv_mbcnt_hi_u32_b32 %0, -1, %0" : "=v"(t)); return t + wave_s * 64; }
__device__ __forceinline__ float shx(float v, int o, int lane) { return __builtin_bit_cast(float, __builtin_amdgcn_ds_bpermute((lane ^ o) << 2, __builtin_bit_cast(int, v))); }
__device__ __forceinline__ float wave_sum(float v, int lane) {
#pragma unroll
    for (int o = 1; o < 64; o <<= 1) v += shx(v, o, lane);
    return v;
}

namespace pg8 {
constexpr int BM = 256, BK = 64, HALF = 128, HTB = HALF * BK * 2, STAGE_BYTES = 8 * HTB, NXCD = 8, WGM = 8;
__host__ __device__ __forceinline__ int lds_byte(int r, int c) { const int st = (r >> 4) * 2 + (c >> 5), rr = r & 15, cc = c & 31, ob = rr * 64 + cc * 2; return st * 1024 + (ob ^ (((ob >> 9) & 1) << 5)); }
__host__ __device__ __forceinline__ void stage_rc(int b, int& R, int& C) { const int st = b / 1024, sb = b % 1024, swz = sb ^ (((sb >> 9) & 1) << 5); R = (st >> 1) * 16 + swz / 64; C = (st & 1) * 32 + (swz % 64) / 2; }
__host__ __device__ __forceinline__ int perm32(int rho) { const int n = rho >> 4, i = rho & 15; return 8 * (i >> 2) + 4 * n + (i & 3); }

struct Unit { const char* A; const char* B; int pm, pn, aux; };

struct OrderMN {
    int nM, nN, nwg, G, c; const char* A; const char* B; size_t tstep; size_t tstepB = 0;
    __device__ __forceinline__ bool next(int i, Unit& u) const {
        const long L = (long)i * G + c; if (L >= nwg) return false;
        int wgid = (int)L; { const int q = nwg / NXCD, r = nwg % NXCD, xcd = wgid % NXCD, off = wgid / NXCD; wgid = (xcd < r ? xcd * (q + 1) : r * (q + 1) + (xcd - r) * q) + off; }
        const int nig = WGM * nN, gid = wgid / nig, fm = gid * WGM, gsz = (nM - fm) < WGM ? (nM - fm) : WGM;
        u.pm = fm + ((wgid % nig) % gsz); u.pn = (wgid % nig) / gsz; u.aux = i;
        u.A = A + (size_t)u.pm * tstep; u.B = B + (size_t)u.pn * (tstepB ? tstepB : tstep); return true;
    }
};
struct OrderMerge {
    int ngrp, nN, G, c; const char* A0; size_t astride; const char* B0; size_t bstride; size_t tstep; size_t tstepB = 0;
    __device__ __forceinline__ bool next(int i, Unit& u) const {
        const int grp = c + (i / 3) * G; if (grp >= ngrp) return false;
        const int j = i % 3; u.pm = grp / nN; u.pn = grp % nN; u.aux = j;
        u.A = A0 + (size_t)j * astride + (size_t)u.pm * tstep; u.B = B0 + (size_t)j * bstride + (size_t)u.pn * (tstepB ? tstepB : tstep); return true;
    }
};

struct NoPre { __device__ __forceinline__ void operator()() const {} };
template <int NH = 2, bool CHAIN = false, class Epi, class Sched, class Pre = NoPre>
__device__ __forceinline__ void gemm_phase(LAS unsigned char* lds, const int K, const Sched& S, const Epi& E, const int wave_s, const Pre& pre = Pre()) {
    const int tid = tid_from_wave(wave_s);
    const int wid = __builtin_amdgcn_readfirstlane(tid >> 6), lane = tid & 63, wr = wid >> 2, wc = wid & 3, fr = lane & 15, fq = lane >> 4;
    const int nt = K / BK;
    unsigned voffA[2], voffB[2];
#pragma unroll
    for (int i = 0; i < 2; ++i) { int R, C; stage_rc(tid * 16 + i * 8192, R, C); const int Rb = (R & ~31) + perm32(R & 31);
        voffA[i] = (unsigned)(R * K + C) * 2u; voffB[i] = (unsigned)(Rb * K + C) * 2u; }
    const size_t kstep = (size_t)(BK * 2);
    const size_t hstep = (size_t)HALF * K * 2;
    const unsigned ldsw = (unsigned)wid * 1024u;
    const int aoff = lds_byte(wr * 64 + fr, fq * 8), boff = lds_byte(wc * 32 + fr, fq * 8);
#define PG8_SA(b, h) (((b) * 2 + (h)) * HTB)
#define PG8_SB(b, h) ((4 + (b) * 2 + (h)) * HTB)
#define PG8_STAGE(bufoff, gbase, voff) do { _Pragma("unroll") for (int _i = 0; _i < 2; ++_i) \
        __builtin_amdgcn_global_load_lds((const unsigned*)((const char*)(gbase) + (voff)[_i]), (LAS unsigned*)(lds + (bufoff) + ldsw + _i * 8192), 16, 0, 0); } while (0)
#define PG8_LDA(dst, b, h) do { _Pragma("unroll") for (int m = 0; m < 4; ++m) _Pragma("unroll") for (int k = 0; k < 2; ++k) dst[m][k] = *(const LAS bf16x8*)(lds + PG8_SA(b, h) + aoff + m * 2048 + k * 1024); } while (0)
#define PG8_LDB(dst, b, h) do { _Pragma("unroll") for (int n = 0; n < 2; ++n) _Pragma("unroll") for (int k = 0; k < 2; ++k) dst[n][k] = *(const LAS bf16x8*)(lds + PG8_SB(b, h) + boff + n * 2048 + k * 1024); } while (0)
#define PG8_MMA(ai, bj, At, Bt) do { __builtin_amdgcn_s_setprio(1); _Pragma("unroll") for (int m = 0; m < 4; ++m) _Pragma("unroll") for (int n = 0; n < 2; ++n) _Pragma("unroll") for (int k = 0; k < 2; ++k) \
        acc[ai][bj][m][n] = __builtin_amdgcn_mfma_f32_16x16x32_bf16(Bt[n][k], At[m][k], acc[ai][bj][m][n], 0, 0, 0); __builtin_amdgcn_s_setprio(0); } while (0)
#define PG8_WAIT_V(n) asm volatile("s_waitcnt vmcnt(" #n ")" ::: "memory")
#define PG8_WAIT_L(n) asm volatile("s_waitcnt lgkmcnt(" #n ")" ::: "memory")
#define PG8_BAR __builtin_amdgcn_s_barrier()
#define PG8_SCHED __builtin_amdgcn_sched_barrier(0)
    Unit cur, nxt; int ui = 0;
    if (!S.next(0, cur)) return;
    f32x4 acc[2][2][4][2];
#pragma unroll
    for (int a = 0; a < 2; ++a)
#pragma unroll
        for (int b = 0; b < 2; ++b)
#pragma unroll
            for (int m = 0; m < 4; ++m)
#pragma unroll
                for (int n = 0; n < 2; ++n) acc[a][b][m][n] = (f32x4){0.f, 0.f, 0.f, 0.f};
    bf16x8 At[4][2], B0[2][2], B1[2][2];
    const char* cA = cur.A; const char* cB = cur.B;
#define PG8_WAIT_STEADY() do { if constexpr (NH == 2) PG8_WAIT_V(8); else PG8_WAIT_V(6); } while (0)
    PG8_STAGE(PG8_SB(0, 0), cB, voffB); if constexpr (NH == 2) PG8_STAGE(PG8_SB(0, 1), cB + hstep, voffB); PG8_STAGE(PG8_SA(0, 0), cA, voffA); PG8_STAGE(PG8_SA(0, 1), cA + hstep, voffA);
    pre();
    if (wr == 1) PG8_BAR;
    PG8_WAIT_V(2); PG8_BAR;
    PG8_STAGE(PG8_SB(1, 0), cB + kstep, voffB); PG8_STAGE(PG8_SA(1, 0), cA + kstep, voffA); if constexpr (NH == 2) PG8_STAGE(PG8_SB(1, 1), cB + hstep + kstep, voffB);
    if constexpr (NH == 2) PG8_WAIT_V(6); else PG8_WAIT_V(4);
    PG8_BAR;
    for (;;) {
        const bool has_next = S.next(ui + 1, nxt);
        const char* nA = has_next ? nxt.A : cA; const char* nB = has_next ? nxt.B : cB;
        for (int t = 0; t < nt; t += 2) {
            const bool last = (t == nt - 2);
            const char* a1 = cA + (size_t)(t + 1) * kstep;
            const char* a2 = last ? nA : cA + (size_t)(t + 2) * kstep; const char* b2 = last ? nB : cB + (size_t)(t + 2) * kstep;
            const char* a3 = a2 + kstep; const char* b3 = b2 + kstep;
            PG8_LDB(B0, 0, 0); if constexpr (NH == 2) PG8_LDB(B1, 0, 1); PG8_SCHED; PG8_LDA(At, 0, 0); PG8_STAGE(PG8_SA(1, 1), a1 + hstep, voffA);
            PG8_WAIT_STEADY(); PG8_WAIT_L(0); PG8_BAR; PG8_MMA(0, 0, At, B0); if constexpr (NH == 2) PG8_MMA(0, 1, At, B1); PG8_BAR; PG8_SCHED;
            PG8_LDA(At, 0, 1); PG8_STAGE(PG8_SB(0, 0), b2, voffB); if constexpr (NH == 2) PG8_STAGE(PG8_SB(0, 1), b2 + hstep, voffB); PG8_STAGE(PG8_SA(0, 0), a2, voffA);
            PG8_WAIT_STEADY(); PG8_WAIT_L(0); PG8_BAR; PG8_MMA(1, 0, At, B0); if constexpr (NH == 2) PG8_MMA(1, 1, At, B1); PG8_BAR; PG8_SCHED;
            PG8_LDB(B0, 1, 0); if constexpr (NH == 2) PG8_LDB(B1, 1, 1); PG8_SCHED; PG8_LDA(At, 1, 0); PG8_STAGE(PG8_SA(0, 1), a2 + hstep, voffA);
            PG8_WAIT_STEADY(); PG8_WAIT_L(0); PG8_BAR; PG8_MMA(0, 0, At, B0); if constexpr (NH == 2) PG8_MMA(0, 1, At, B1); PG8_BAR; PG8_SCHED;
            PG8_LDA(At, 1, 1); PG8_STAGE(PG8_SB(1, 0), b3, voffB); if constexpr (NH == 2) PG8_STAGE(PG8_SB(1, 1), b3 + hstep, voffB); PG8_STAGE(PG8_SA(1, 0), a3, voffA);
            PG8_WAIT_STEADY(); PG8_WAIT_L(0); PG8_BAR; PG8_MMA(1, 0, At, B0); if constexpr (NH == 2) PG8_MMA(1, 1, At, B1); PG8_BAR; PG8_SCHED;
        }
        if (wr == 0) PG8_BAR;
        bool chained = false;
        { const int l2_ = tid_from_wave(wave_s) & 63; const int fr_ = l2_ & 15, fq_ = l2_ >> 4;
          if constexpr (CHAIN) { if (cur.aux < 2) { E.mid(acc, cur, wr, wc, fr_, fq_); chained = true; } else E(acc, cur, wr, wc, fr_, fq_); }
          else E(acc, cur, wr, wc, fr_, fq_); }
        if (!has_next) break;
        if (!chained)
#pragma unroll
        for (int a = 0; a < 2; ++a)
#pragma unroll
            for (int b = 0; b < 2; ++b)
#pragma unroll
                for (int m = 0; m < 4; ++m)
#pragma unroll
                    for (int n = 0; n < 2; ++n) acc[a][b][m][n] = (f32x4){0.f, 0.f, 0.f, 0.f};
        cur = nxt; cA = nA; cB = nB; ++ui;
        if (wr == 1) PG8_BAR;
    }
    PG8_WAIT_V(0);
    PG8_BAR;
#undef PG8_SA
#undef PG8_SB
#undef PG8_STAGE
#undef PG8_LDA
#undef PG8_LDB
#undef PG8_MMA
#undef PG8_WAIT_STEADY
#undef PG8_WAIT_V
#undef PG8_WAIT_L
#undef PG8_BAR
#undef PG8_SCHED
}
}
using pg8::Unit;

#define INVA_LIST {1.0f, 0.5623413251903491f, 0.31622776601683794f, 0.1778279410038923f, 0.1f, 0.05623413251903491f, 0.03162277660168379f, 0.01778279410038923f, \
                   0.01f, 0.005623413251903491f, 0.0031622776601683794f, 0.0017782794100389228f, 0.001f, 0.0005623413251903491f, 0.00031622776601683794f, 0.00017782794100389227f}
#define INVB_LIST {1.0f, 0.31622776601683794f, 0.1f, 0.03162277660168379f, 0.01f, 0.0031622776601683794f, 0.001f, 0.00031622776601683794f}
__device__ __forceinline__ void rope_cs(float p, float inv, float& c, float& s) { const float a = p * inv; c = __cosf(a); s = __sinf(a); }

struct EpiInProj {
    unsigned char* pb;
    __device__ __forceinline__ void operator()(const f32x4 (&acc)[2][2][4][2], const Unit& u, int wr, int wc, int fr, int fq) const {
        const int pn = u.pn;
        bf16_t *QA = (bf16_t*)(pb + B_QA), *KA = (bf16_t*)(pb + B_KA), *VAT = (bf16_t*)(pb + B_VAT), *QLAT = (bf16_t*)(pb + B_QLAT), *KVLAT = (bf16_t*)(pb + B_KVLAT),
               *KB = (bf16_t*)(pb + B_KB), *YA = (bf16_t*)(pb + B_YA), *YB = (bf16_t*)(pb + B_YB), *PC = (bf16_t*)(pb + B_PC), *ZC = (bf16_t*)(pb + B_ZC), *G = (bf16_t*)(pb + B_G);
#pragma unroll
        for (int ai = 0; ai < 2; ++ai)
#pragma unroll
            for (int m = 0; m < 4; ++m) {
                const int row = u.pm * 256 + ai * 128 + wr * 64 + m * 16 + fr;
                const bool lat = row < SEQ; const float prow = (float)(row >> 6), pcol = (float)(row & 63);
                if (pn <= 2) {
                    if (pn < 2 || wc < 2) {
                        f32x4 o1[2], o2[2];
                        const float p = (fq < 2) ? prow : pcol;
#pragma unroll
                        for (int n = 0; n < 2; ++n)
#pragma unroll
                            for (int j = 0; j < 4; ++j) {
                                constexpr float IA[16] = INVA_LIST; float c = 1.f, s = 0.f;
                                if (lat) rope_cs(p, (fq & 1) ? IA[8 + 4 * n + j] : IA[4 * n + j], c, s);
                                const float x1 = acc[ai][0][m][n][j], x2 = acc[ai][1][m][n][j];
                                o1[n][j] = x1 * c - x2 * s; o2[n][j] = x2 * c + x1 * s;
                            }
                        if (pn < 2) {
                            const int head = 4 * pn + wc; bf16_t* dst = QA + (size_t)row * 512 + head * 64 + 8 * fq;
                            *(u32x4*)dst = pack8(o1[0] * QS_A, o1[1] * QS_A); *(u32x4*)(dst + 32) = pack8(o2[0] * QS_A, o2[1] * QS_A);
                        } else {
                            bf16_t* dst = KA + (size_t)row * 128 + wc * 64 + 8 * fq;
                            *(u32x4*)dst = pack8(o1[0], o1[1]); *(u32x4*)(dst + 32) = pack8(o2[0], o2[1]);
                        }
                    } else {
#pragma unroll
                        for (int bj = 0; bj < 2; ++bj)
#pragma unroll
                            for (int n = 0; n < 2; ++n)
#pragma unroll
                                for (int j = 0; j < 4; ++j) { const int d = (wc - 2) * 32 + 8 * fq + 4 * n + j;
                                    VAT[(size_t)(bj * 64 + d) * RB + row] = (bf16_t)(pk2(acc[ai][bj][m][n][j], 0.f) & 0xffffu); }
                    }
                } else if (pn <= 4 || pn == 8 || pn == 9) {
                    bf16_t* Y = (pn <= 4) ? YA : YB; const int t = (pn <= 4) ? pn - 3 : pn - 8;
#pragma unroll
                    for (int bj = 0; bj < 2; ++bj) { f32x4 a = acc[ai][bj][m][0], b = acc[ai][bj][m][1];
#pragma unroll
                        for (int j = 0; j < 4; ++j) { a[j] = siluf_(a[j]); b[j] = siluf_(b[j]); }
                        *(u32x4*)(Y + (size_t)row * 512 + t * 256 + bj * 128 + wc * 32 + 8 * fq) = pack8(a, b); }
                } else if (pn <= 7) {
#pragma unroll
                    for (int bj = 0; bj < 2; ++bj) {
                        const int lv = (pn - 5) * 256 + bj * 128 + wc * 32 + 8 * fq;
                        if (lv < 384) *(u32x4*)(QLAT + (size_t)row * 384 + lv) = pack8(acc[ai][bj][m][0], acc[ai][bj][m][1]);
                        else if (lv < 640) *(u32x4*)(KVLAT + (size_t)row * 256 + (lv - 384)) = pack8(acc[ai][bj][m][0], acc[ai][bj][m][1]);
                        else if (pn == 7 && bj == 1 && wc == 0) {
                            f32x4 o[2]; const float p = (fq & 1) ? pcol : prow;
#pragma unroll
                            for (int n = 0; n < 2; ++n)
#pragma unroll
                                for (int j = 0; j < 4; ++j) {
                                    const float mine = acc[ai][bj][m][n][j]; const float partner = shx(mine, 32, fr + 16 * fq);
                                    constexpr float IB[8] = INVB_LIST; float c = 1.f, s = 0.f; if (lat) rope_cs(p, IB[4 * n + j], c, s);
                                    o[n][j] = mine * c + ((fq < 2) ? -partner : partner) * s;
                                }
                            const u32x4 w = pack8(o[0], o[1]);
#pragma unroll
                            for (int h = 0; h < 8; ++h) *(u32x4*)(KB + (size_t)row * 768 + h * 96 + 64 + 8 * fq) = w;
                        }
                    }
                } else if (pn <= 17) {
                    const int ch = (pn - 10) * 64 + wc * 16 + fq * 4;
                    const f32x4 bc = acc[ai][0][m][0], cc = acc[ai][0][m][1], uc = acc[ai][1][m][0], zc = acc[ai][1][m][1];
                    f32x4 pv, zv;
#pragma unroll
                    for (int j = 0; j < 4; ++j) { pv[j] = bc[j] * siluf_(zc[j]); zv[j] = cc[j] * uc[j]; }
                    u32x2 pw, zw; pw.x = pk2(pv[0], pv[1]); pw.y = pk2(pv[2], pv[3]); zw.x = pk2(zv[0], zv[1]); zw.y = pk2(zv[2], zv[3]);
                    *(u32x2*)(PC + (size_t)row * 512 + ch) = pw; *(u32x2*)(ZC + (size_t)row * 512 + ch) = zw;
                } else {
#pragma unroll
                    for (int bj = 0; bj < 2; ++bj) { f32x4 a = acc[ai][bj][m][0], b = acc[ai][bj][m][1];
#pragma unroll
                        for (int j = 0; j < 4; ++j) { a[j] = sigmoidf_(a[j]); b[j] = sigmoidf_(b[j]); }
                        *(u32x4*)(G + (size_t)row * 3072 + (pn - 18) * 256 + bj * 128 + wc * 32 + 8 * fq) = pack8(a, b); }
                }
                asm volatile("" ::: "memory");
            }
    }
};

template <int NC, class Sched> __device__ __forceinline__ void rstd_table(LAS float* tab, const bf16_t* X, const Sched& S, const int wave_s) {
    const int tid = tid_from_wave(wave_s);
    for (int i = 0; i < 8; ++i) { Unit u; if (!S.next(i, u)) break;
        const bf16_t* rp = X + (size_t)(u.pm * 256 + (tid >> 1)) * NC + (tid & 1) * (NC / 2); float s = 0.f;
#pragma unroll
        for (int c = 0; c < NC / 16; ++c) { const u32x4 w = *(const u32x4*)(rp + c * 8);
            const float a0 = bflo(w.x), a1 = bfhi(w.x), a2 = bflo(w.y), a3 = bfhi(w.y), a4 = bflo(w.z), a5 = bfhi(w.z), a6 = bflo(w.w), a7 = bfhi(w.w);
            s += (a0 * a0 + a1 * a1) + (a2 * a2 + a3 * a3) + (a4 * a4 + a5 * a5) + (a6 * a6 + a7 * a7); }
        s += shx(s, 1, tid & 63);
        if ((tid & 1) == 0) tab[i * 256 + (tid >> 1)] = __builtin_amdgcn_rsqf(s * (1.0f / NC) + EPS);
    }
    __syncthreads();
}

template <int NC, class Sched> struct RstdHook { LAS float* tab; const bf16_t* X; const Sched* S; int wave_s;
    __device__ __forceinline__ void operator()() const { rstd_table<NC>(tab, X, *S, wave_s); } };

struct EpiUpQ {
    unsigned char* pb; const LAS float* tab;
    __device__ __forceinline__ void operator()(const f32x4 (&acc)[2][2][4][2], const Unit& u, int wr, int wc, int fr, int fq) const {
        const int pn = u.pn; bf16_t* QB = (bf16_t*)(pb + B_QB);
#pragma unroll
        for (int ai = 0; ai < 2; ++ai)
#pragma unroll
            for (int m = 0; m < 4; ++m) {
                const int row = u.pm * 256 + ai * 128 + wr * 64 + m * 16 + fr;
                const float qs = tab[u.aux * 256 + ai * 128 + wr * 64 + m * 16 + fr] * QS_B;
                if (pn < 2) {
#pragma unroll
                    for (int bj = 0; bj < 2; ++bj) { const int v0 = pn * 256 + bj * 128 + wc * 32 + 8 * fq; const int head = v0 >> 6, d = v0 & 63;
                        *(u32x4*)(QB + (size_t)row * 768 + head * 96 + d) = pack8(acc[ai][bj][m][0] * qs, acc[ai][bj][m][1] * qs); }
                } else {
                    const bool lat = row < SEQ; const float p = (fq & 1) ? (float)(row & 63) : (float)(row >> 6);
                    f32x4 o1[2], o2[2];
#pragma unroll
                    for (int n = 0; n < 2; ++n)
#pragma unroll
                        for (int j = 0; j < 4; ++j) { constexpr float IB[8] = INVB_LIST; float c = 1.f, s = 0.f; if (lat) rope_cs(p, IB[4 * n + j], c, s);
                            const float x1 = acc[ai][0][m][n][j], x2 = acc[ai][1][m][n][j]; o1[n][j] = (x1 * c - x2 * s) * qs; o2[n][j] = (x2 * c + x1 * s) * qs; }
                    const int head = 2 * wc + (fq >> 1); bf16_t* dst = QB + (size_t)row * 768 + head * 96 + 64 + 8 * (fq & 1);
                    *(u32x4*)dst = pack8(o1[0], o1[1]); *(u32x4*)(dst + 16) = pack8(o2[0], o2[1]);
                }
                asm volatile("" ::: "memory");
            }
    }
};
struct EpiUpKV {
    unsigned char* pb; const LAS float* tab;
    __device__ __forceinline__ void operator()(const f32x4 (&acc)[2][2][4][2], const Unit& u, int wr, int wc, int fr, int fq) const {
        const int pn = u.pn; bf16_t* KB = (bf16_t*)(pb + B_KB); bf16_t* VBT = (bf16_t*)(pb + B_VBT);
#pragma unroll
        for (int ai = 0; ai < 2; ++ai)
#pragma unroll
            for (int m = 0; m < 4; ++m) {
                const int row = u.pm * 256 + ai * 128 + wr * 64 + m * 16 + fr;
                const float rs = tab[u.aux * 256 + ai * 128 + wr * 64 + m * 16 + fr];
#pragma unroll
                for (int bj = 0; bj < 2; ++bj) {
                    const int v0 = (pn & 1) * 256 + bj * 128 + wc * 32 + 8 * fq; const int head = v0 >> 6, d = v0 & 63;
                    if (pn < 2) *(u32x4*)(KB + (size_t)row * 768 + head * 96 + d) = pack8(acc[ai][bj][m][0] * rs, acc[ai][bj][m][1] * rs);
                    else {
#pragma unroll
                        for (int n = 0; n < 2; ++n)
#pragma unroll
                            for (int j = 0; j < 4; ++j) VBT[(size_t)(head * 64 + d + 4 * n + j) * RB + row] = (bf16_t)(pk2(acc[ai][bj][m][n][j] * rs, 0.f) & 0xffffu);
                    }
                }
                asm volatile("" ::: "memory");
            }
    }
};
struct EpiMerge {
    unsigned char* pb; int nbj;
    __device__ __forceinline__ void mid(f32x4 (&acc)[2][2][4][2], const Unit& u, int wr, int wc, int fr, int fq) const {
        const int j = u.aux; const bf16_t* G = (const bf16_t*)(pb + B_G);
#pragma unroll
        for (int ai = 0; ai < 2; ++ai) {
            u32x4 g0[4][2], g1[4][2];
#pragma unroll
            for (int m = 0; m < 4; ++m) { const int row = u.pm * 256 + ai * 128 + wr * 64 + m * 16 + fr;
#pragma unroll
                for (int bj = 0; bj < 2; ++bj) { if (bj >= nbj) break;
                    const bf16_t* gp = G + (size_t)row * 3072 + j * 1024 + u.pn * 128 * nbj + bj * 128 + wc * 32 + 8 * fq;
                    g0[m][bj] = *(const u32x4*)gp; g1[m][bj] = *(const u32x4*)(gp + 1024); } }
#pragma unroll
            for (int m = 0; m < 4; ++m)
#pragma unroll
                for (int bj = 0; bj < 2; ++bj) { if (bj >= nbj) break;
                    const u32x4 x = g0[m][bj], y = g1[m][bj];
#define RT_(a_, b_) ((a_) * __builtin_amdgcn_rcpf(fmaxf((b_), 1e-30f)))
                    acc[ai][bj][m][0][0] *= RT_(bflo(x.x), bflo(y.x)); acc[ai][bj][m][0][1] *= RT_(bfhi(x.x), bfhi(y.x)); acc[ai][bj][m][0][2] *= RT_(bflo(x.y), bflo(y.y)); acc[ai][bj][m][0][3] *= RT_(bfhi(x.y), bfhi(y.y));
                    acc[ai][bj][m][1][0] *= RT_(bflo(x.z), bflo(y.z)); acc[ai][bj][m][1][1] *= RT_(bfhi(x.z), bfhi(y.z)); acc[ai][bj][m][1][2] *= RT_(bflo(x.w), bflo(y.w)); acc[ai][bj][m][1][3] *= RT_(bfhi(x.w), bfhi(y.w));
#undef RT_
                }
            asm volatile("" ::: "memory");
        }
    }
    __device__ __forceinline__ void operator()(const f32x4 (&acc)[2][2][4][2], const Unit& u, int wr, int wc, int fr, int fq) const {
        const int j = u.aux; const bf16_t* G = (const bf16_t*)(pb + B_G); bf16_t* M = (bf16_t*)(pb + B_M);
#pragma unroll
        for (int ai = 0; ai < 2; ++ai) {
            u32x4 g[4][2];
#pragma unroll
            for (int m = 0; m < 4; ++m) { const int row = u.pm * 256 + ai * 128 + wr * 64 + m * 16 + fr;
#pragma unroll
                for (int bj = 0; bj < 2; ++bj) { if (bj >= nbj) break;
                    g[m][bj] = *(const u32x4*)(G + (size_t)row * 3072 + j * 1024 + u.pn * 128 * nbj + bj * 128 + wc * 32 + 8 * fq); } }
#pragma unroll
            for (int m = 0; m < 4; ++m) { const int row = u.pm * 256 + ai * 128 + wr * 64 + m * 16 + fr;
#pragma unroll
                for (int bj = 0; bj < 2; ++bj) { if (bj >= nbj) break;
                    const int col = u.pn * 128 * nbj + bj * 128 + wc * 32 + 8 * fq;
                    const u32x4 gg = g[m][bj];
                    f32x4 a = acc[ai][bj][m][0], b2 = acc[ai][bj][m][1];
                    a[0] *= bflo(gg.x); a[1] *= bfhi(gg.x); a[2] *= bflo(gg.y); a[3] *= bfhi(gg.y); b2[0] *= bflo(gg.z); b2[1] *= bfhi(gg.z); b2[2] *= bflo(gg.w); b2[3] *= bfhi(gg.w);
                    *(u32x4*)(M + (size_t)row * 1024 + col) = pack8(a, b2); } }
            asm volatile("" ::: "memory");
        }
    }
};
struct EpiOut {
    bf16_t* O; int nbj;
    __device__ __forceinline__ void operator()(const f32x4 (&acc)[2][2][4][2], const Unit& u, int wr, int wc, int fr, int fq) const {
#pragma unroll
        for (int ai = 0; ai < 2; ++ai)
#pragma unroll
            for (int m = 0; m < 4; ++m) {
                const int row = u.pm * 256 + ai * 128 + wr * 64 + m * 16 + fr;
#pragma unroll
                for (int bj = 0; bj < 2; ++bj) { if (bj >= nbj) break;
                    *(u32x4*)(O + (size_t)row * 1024 + u.pn * 128 * nbj + bj * 128 + wc * 32 + 8 * fq) = pack8(acc[ai][bj][m][0], acc[ai][bj][m][1]); }
            }
    }
};

template <int DQK, bool WIN>
__device__ __forceinline__ void attn_unit(LAS unsigned char* lds, const bf16_t* __restrict__ Q, const int qpitch, const bf16_t* __restrict__ Kp, const int kpitch,
                                          const bf16_t* __restrict__ VT, bf16_t* Y, const int q0, const int a0, const int n1, const int b0, const int n2,
                                          const float m_init, const float l_init, const int wave_s, const bool do_store = true) {
    constexpr int CPR = DQK / 8, KROW = DQK * 2, KSLOT = 64 * KROW, VSLOT = 8192, NS = 4, KI = KSLOT / 1024, ND = DQK / 16, VBASE = NS * KSLOT;
    const int tid = tid_from_wave(wave_s);
    const int lane = tid & 63, wid = wave_s, r32 = lane & 31, hi = lane >> 5;
    const int NT = n1 + n2;
    int ksrc[2];
#pragma unroll
    for (int i = 0; i < 2; ++i) { const int cc = 64 * (wid + 8 * i) + lane; const int rho = cc / CPR, pos = cc % CPR;
        const int ch = (DQK == 96) ? ((pos & ~3) | ((pos & 3) ^ ((rho >> 2) & 3))) : (pos ^ ((rho >> 1) & 7));
        const int key = (rho & ~12) | ((rho & 4) << 1) | ((rho & 8) >> 1);
        ksrc[i] = key * kpitch + ch * 8; }
    int vsrc; { const int cc = 64 * wid + lane; const int d = cc >> 3, pos = cc & 7; vsrc = d * RB + ((pos ^ ((d >> 1) & 7)) * 8); }
    const bool k2 = (wid + 8 < KI);
    int kofs[ND], vofs[4];
#pragma unroll
    for (int d0 = 0; d0 < ND; ++d0) { const int c = 2 * d0 + hi; const int pos = (DQK == 96) ? ((c & ~3) | ((c & 3) ^ ((r32 >> 2) & 3))) : (c ^ ((r32 >> 1) & 7)); kofs[d0] = r32 * KROW + pos * 16; }
#pragma unroll
    for (int sl = 0; sl < 4; ++sl) vofs[sl] = r32 * 128 + (((2 * sl + hi) ^ ((r32 >> 1) & 7)) * 16);
    const int qrow = q0 + wid * 32 + r32;
    bf16x8 qf[ND];
    { const bf16_t* qp = Q + (size_t)qrow * qpitch + hi * 8;
#pragma unroll
      for (int d0 = 0; d0 < ND; ++d0) qf[d0] = *(const bf16x8*)(qp + d0 * 16); }
    f32x16 o0, o1;
#pragma unroll
    for (int r = 0; r < 16; ++r) { o0[r] = 0.f; o1[r] = 0.f; }
    float mrun = m_init, lrun = (hi == 0) ? l_init : 0.f;
#define TROW(t) ((t) < n1 ? a0 + 64 * (t) : b0 + 64 * ((t) - n1))
#define DMA_K(t, slot) do { const int tt_ = ((t) < NT) ? (t) : NT - 1; const bf16_t* kb_ = Kp + (size_t)TROW(tt_) * kpitch; \
        __builtin_amdgcn_global_load_lds((const unsigned*)(kb_ + ksrc[0]), (LAS unsigned*)(lds + (slot) * KSLOT + wid * 1024), 16, 0, 0); \
        if (k2) __builtin_amdgcn_global_load_lds((const unsigned*)(kb_ + ksrc[1]), (LAS unsigned*)(lds + (slot) * KSLOT + (wid + 8) * 1024), 16, 0, 0); } while (0)
#define DMA_V(t, slot) do { const int tt_ = ((t) < NT) ? (t) : NT - 1; \
        __builtin_amdgcn_global_load_lds((const unsigned*)(VT + TROW(tt_) + vsrc), (LAS unsigned*)(lds + VBASE + (slot) * VSLOT + wid * 1024), 16, 0, 0); } while (0)
#define QKT(S0, S1, slot) do { const LAS unsigned char* Kb_ = lds + (slot) * KSLOT; \
        _Pragma("unroll") for (int d0 = 0; d0 < ND; ++d0) { \
            const bf16x8 k0_ = *(const LAS bf16x8*)(Kb_ + kofs[d0]); const bf16x8 k1_ = *(const LAS bf16x8*)(Kb_ + 32 * KROW + kofs[d0]); \
            S0 = __builtin_amdgcn_mfma_f32_32x32x16_bf16(k0_, qf[d0], S0, 0, 0, 0); S1 = __builtin_amdgcn_mfma_f32_32x32x16_bf16(k1_, qf[d0], S1, 0, 0, 0); } } while (0)
    DMA_K(0, 0); DMA_K(1, 1); DMA_V(0, 0); DMA_K(2, 2); DMA_V(1, 1);
    asm volatile("s_waitcnt vmcnt(0) lgkmcnt(0)\n\ts_barrier" ::: "memory");
    f32x16 s0, s1;
#pragma unroll
    for (int r = 0; r < 16; ++r) { s0[r] = 0.f; s1[r] = 0.f; }
    QKT(s0, s1, 0);
    const f32x16 zero16 = {0.f, 0.f, 0.f, 0.f, 0.f, 0.f, 0.f, 0.f, 0.f, 0.f, 0.f, 0.f, 0.f, 0.f, 0.f, 0.f};
#define MASKT(S0, S1, T) do { if (WIN) { const int kt_ = TROW(T); \
          if (kt_ < SEQ) { const int base_ = kt_ + 8 * hi - qrow; \
              _Pragma("unroll") for (int r = 0; r < 16; ++r) { const int dd_ = base_ + 16 * (r >> 3) + (r & 7); \
                  if (dd_ > 128 || dd_ < -128) S0[r] = NEG; if (dd_ + 32 > 128 || dd_ + 32 < -128) S1[r] = NEG; } } } } while (0)
#define ROWMAX(MX, S0, S1) do { MX = fmaxf(fmaxf(S0[0], S1[0]), S0[1]); \
      _Pragma("unroll") for (int r = 1; r < 16; ++r) { MX = fmaxf(fmaxf(MX, S1[r]), (r < 15) ? S0[r + 1] : S1[r]); } \
      { auto rr_ = __builtin_amdgcn_permlane32_swap(__float_as_uint(MX), __float_as_uint(MX), false, false); MX = fmaxf(__uint_as_float(rr_[0]), __uint_as_float(rr_[1])); } } while (0)
    float mxn;
    { MASKT(s0, s1, 0);
      float mx; ROWMAX(mx, s0, s1);
      const float m0 = fmaxf(m_init, mx);
      lrun *= fexp2(m_init - m0); mrun = m0; mxn = m0; }
    bool resc = false;
#define LOADKF(T1) do { const LAS unsigned char* Kb_ = lds + ((T1) & 3) * KSLOT; \
          _Pragma("unroll") for (int d0 = 0; d0 < ND; ++d0) { kf0[d0] = *(const LAS bf16x8*)(Kb_ + kofs[d0]); kf1[d0] = *(const LAS bf16x8*)(Kb_ + 32 * KROW + kofs[d0]); } } while (0)
    bf16x8 kf0[ND], kf1[ND];
    LOADKF(1);
#define STEP(S0, S1, N0, N1, T) do { \
        DMA_K((T) + 3, ((T) + 3) & 3); DMA_V((T) + 2, ((T) + 2) & 3); \
        if (resc) {                                 \
            const float dl = fmaxf(mxn - mrun, 0.f); mrun += dl; const float alpha = fexp2(-dl); lrun *= alpha; \
            _Pragma("unroll") for (int r = 0; r < 16; ++r) { o0[r] *= alpha; o1[r] *= alpha; } } \
        N0 = __builtin_amdgcn_mfma_f32_32x32x16_bf16(kf0[0], qf[0], zero16, 0, 0, 0); N1 = __builtin_amdgcn_mfma_f32_32x32x16_bf16(kf1[0], qf[0], zero16, 0, 0, 0); \
        _Pragma("unroll") for (int d0 = 1; d0 < ND; ++d0) { N0 = __builtin_amdgcn_mfma_f32_32x32x16_bf16(kf0[d0], qf[d0], N0, 0, 0, 0); N1 = __builtin_amdgcn_mfma_f32_32x32x16_bf16(kf1[d0], qf[d0], N1, 0, 0, 0); } \
        asm volatile("" ::: "memory");              \
        bf16x8 vfa[4], vfc[4]; \
        { const LAS unsigned char* Vb_ = lds + VBASE + ((T) & 3) * VSLOT; \
          _Pragma("unroll") for (int sl = 0; sl < 4; ++sl) { vfa[sl] = *(const LAS bf16x8*)(Vb_ + vofs[sl]); vfc[sl] = *(const LAS bf16x8*)(Vb_ + 4096 + vofs[sl]); } } \
        float ps = 0.f; \
        _Pragma("unroll") for (int r = 0; r < 16; ++r) { S0[r] = fexp2(S0[r] - mrun); S1[r] = fexp2(S1[r] - mrun); ps += S0[r] + S1[r]; } \
        lrun += ps; \
        u32x4 pb[4]; \
        _Pragma("unroll") for (int h2 = 0; h2 < 2; ++h2) { \
            pb[h2] = (u32x4){pk2(S0[8 * h2], S0[8 * h2 + 1]), pk2(S0[8 * h2 + 2], S0[8 * h2 + 3]), pk2(S0[8 * h2 + 4], S0[8 * h2 + 5]), pk2(S0[8 * h2 + 6], S0[8 * h2 + 7])}; \
            pb[2 + h2] = (u32x4){pk2(S1[8 * h2], S1[8 * h2 + 1]), pk2(S1[8 * h2 + 2], S1[8 * h2 + 3]), pk2(S1[8 * h2 + 4], S1[8 * h2 + 5]), pk2(S1[8 * h2 + 6], S1[8 * h2 + 7])}; } \
          \
          \
        if (k2) asm volatile("s_waitcnt vmcnt(3) lgkmcnt(0)\n\ts_barrier" : "+v"(pb[0]), "+v"(pb[1]), "+v"(pb[2]), "+v"(pb[3]), "+v"(lrun) :: "memory"); \
        else asm volatile("s_waitcnt vmcnt(2) lgkmcnt(0)\n\ts_barrier" : "+v"(pb[0]), "+v"(pb[1]), "+v"(pb[2]), "+v"(pb[3]), "+v"(lrun) :: "memory"); \
        LOADKF((T) + 2); \
        _Pragma("unroll") for (int sl = 0; sl < 4; ++sl) { \
            o0 = __builtin_amdgcn_mfma_f32_32x32x16_bf16(vfa[sl], __builtin_bit_cast(bf16x8, pb[sl]), o0, 0, 0, 0); \
            o1 = __builtin_amdgcn_mfma_f32_32x32x16_bf16(vfc[sl], __builtin_bit_cast(bf16x8, pb[sl]), o1, 0, 0, 0); } \
        MASKT(N0, N1, (T) + 1); \
        ROWMAX(mxn, N0, N1); \
        resc = __any(mxn - mrun > 8.0f); \
    } while (0)
    f32x16 u0, u1;
    if (wid >= 4) __builtin_amdgcn_s_setprio(1);
    for (int t = 0; t < NT; t += 2) {
        STEP(s0, s1, u0, u1, t);
        STEP(u0, u1, s0, s1, t + 1);
    }
#undef STEP
#undef LOADKF
#undef MASKT
#undef ROWMAX
    __builtin_amdgcn_s_setprio(0);
    asm volatile("s_waitcnt vmcnt(0) lgkmcnt(0)\n\ts_barrier" ::: "memory");
#undef TROW
#undef DMA_K
#undef DMA_V
#undef QKT
    lrun += shx(lrun, 32, lane);
    const float inv = 1.0f / lrun;
    bf16_t* yrow = Y + (size_t)qrow * 512;
#pragma unroll
    for (int db = 0; db < 2; ++db)
#pragma unroll
        for (int g = 0; g < 4; ++g) {
            const int d0 = 32 * db + 8 * g + 4 * hi; u32x2* yp = (u32x2*)(yrow + d0); const u32x2 z = *yp;
            const f32x16& o = db ? o1 : o0; u32x2 w;
            w.x = pk2(o[4 * g] * inv * bflo(z.x), o[4 * g + 1] * inv * bfhi(z.x)); w.y = pk2(o[4 * g + 2] * inv * bflo(z.y), o[4 * g + 3] * inv * bfhi(z.y));
            if (do_store) *yp = w;
        }
}

#define XB_TMO      128
#define XB_XCNT(j)  (256  + 64 * (j))
#define XB_XSUB(j)  (1280 + 64 * (j))
#define XB_XGEN(j)  (2304 + 64 * (j))
#define XB_TOP      3328
#define XB_TOPGEN   3392
#define XCD_BAR_WORDS 3456
#define XB_SPIN_CAP (1u << 18)

__device__ __forceinline__ unsigned xb_ld(unsigned* p)              { return __hip_atomic_load(p, __ATOMIC_RELAXED, __HIP_MEMORY_SCOPE_AGENT); }
__device__ __forceinline__ unsigned xb_add(unsigned* p, unsigned v) { return __hip_atomic_fetch_add(p, v, __ATOMIC_RELAXED, __HIP_MEMORY_SCOPE_AGENT); }
__device__ __forceinline__ unsigned xb_xcc_id() { return (unsigned)__builtin_amdgcn_s_getreg((3 << 11) | 20) & 0xFu; }
#define XB_SPIN(cond, bar) do { unsigned _sp = 0; while (cond) { __builtin_amdgcn_s_sleep(1); \
    if ((++_sp & 255u) == 0u) { if (xb_ld(&(bar)[XB_TMO])) break; if (_sp > XB_SPIN_CAP) { atomicAdd(&(bar)[XB_TMO], 1u); break; } } } } while (0)

struct XcdBarrier {
    unsigned* bar; unsigned x;
    volatile LAS unsigned* st;
};

__device__ __forceinline__ XcdBarrier xcd_barrier_post(unsigned* bar, volatile LAS unsigned* st, const int wave_s) {
    XcdBarrier b; b.bar = bar; b.x = xb_xcc_id(); b.st = st;
    if (tid_from_wave(wave_s) == 0) (void)xb_add(&bar[XB_XCNT(b.x)], 1u);
    return b;
}
__device__ __forceinline__ void xcd_barrier_complete(unsigned* bar, unsigned x, unsigned& nloc, unsigned& nx) {
    const unsigned G = gridDim.x * gridDim.y * gridDim.z;
    unsigned sum, cnt, mine, sp = 0u;
    for (;;) {
        sum = 0u; cnt = 0u; mine = 0u;
#pragma unroll
        for (unsigned j = 0; j < 16; ++j) { const unsigned c = xb_ld(&bar[XB_XCNT(j)]); sum += c; cnt += (c > 0u) ? 1u : 0u; mine = (j == x) ? c : mine; }
        if (sum == G) break;
        __builtin_amdgcn_s_sleep(1);
        if ((++sp & 255u) == 0u) { if (xb_ld(&bar[XB_TMO])) break; if (sp > XB_SPIN_CAP) { atomicAdd(&bar[XB_TMO], 1u); break; } }
    }
    nloc = mine > 0u ? mine : 1u; nx = cnt > 0u ? cnt : 1u;
}

__device__ __forceinline__ void xcd_barrier(const XcdBarrier& b, const int wave_s) {
    asm volatile("s_waitcnt vmcnt(0)" ::: "memory");
    __syncthreads();
    if (tid_from_wave(wave_s) == 0) {
        unsigned* bar = b.bar;
        __builtin_amdgcn_s_waitcnt(0);
        unsigned nloc = b.st[0], nx = b.st[1];
        if (nloc == 0u) { xcd_barrier_complete(bar, b.x, nloc, nx); b.st[0] = nloc; b.st[1] = nx; }
        const unsigned old = xb_add(&bar[XB_XSUB(b.x)], 1u);
        const unsigned gen = old / nloc;
        if (old + 1u == (gen + 1u) * nloc) {
            __builtin_amdgcn_fence(__ATOMIC_RELEASE, "agent");
            asm volatile("s_waitcnt vmcnt(0)" ::: "memory");
            const unsigned og = xb_add(&bar[XB_TOP], 1u);
            const unsigned tg = og / nx;
            if (og + 1u == (tg + 1u) * nx) xb_add(&bar[XB_TOPGEN], 1u);
            else XB_SPIN(xb_ld(&bar[XB_TOPGEN]) == tg, bar);
            __builtin_amdgcn_fence(__ATOMIC_ACQUIRE, "agent");
            xb_add(&bar[XB_XGEN(b.x)], 1u);
            asm volatile("s_waitcnt vmcnt(0)" ::: "memory");
        } else {
            XB_SPIN(xb_ld(&bar[XB_XGEN(b.x)]) == gen, bar);
            __builtin_amdgcn_fence(__ATOMIC_ACQUIRE, "agent");
            asm volatile("s_waitcnt vmcnt(0)" ::: "memory");
        }
    }
    __syncthreads();
}


__device__ __forceinline__ int map_in(int v) {
    const int pn = v >> 8, bj = (v >> 7) & 1, u = v & 127;
    if (pn < 2) return (4 * pn + (u >> 5)) * 64 + (u & 31) + 32 * bj;
    if (pn == 2) return (u < 64) ? 512 + (u >> 5) * 64 + (u & 31) + 32 * bj : 640 + bj * 64 + (u - 64);
    if (pn <= 4) return v;
    if (pn <= 7) { const int lv = v - 1280; return lv < 384 ? 1280 + lv : (lv < 640 ? 1664 + (lv - 384) : (lv < 672 ? 1920 + (lv - 640) : -1)); }
    if (pn <= 9) return 1952 + (v - 2048);
    if (pn <= 17) { const int wc = u >> 5, fq = (u >> 3) & 3, n = (u >> 2) & 1, j = u & 3; const int ch = (pn - 10) * 64 + wc * 16 + fq * 4 + j; return 2464 + (2 * bj + n) * 512 + ch; }
    return 4512 + (v - 4608);
}
__device__ __forceinline__ int map_qb(int v) { if (v < 512) return (v >> 6) * 96 + (v & 63); const int bj = (v >> 7) & 1, u = v & 127; return (u >> 4) * 96 + 64 + (u & 15) + 16 * bj; }
__device__ __forceinline__ int map_kvb(int v) { if (v < 512) return (v >> 6) * 128 + (v & 63); const int w = v - 512; return (w >> 6) * 128 + 64 + (w & 63); }

template <int MAP> __device__ __forceinline__ void transpose_item(const float* __restrict__ W, int K, int N, bf16_t* WT, const float* gk, LAS float* scr, int item, int nblk, int lane) {
    const int kb = item / nblk, nb = item % nblk, k0 = 64 * kb, v0 = 32 * nb;
    const int kr = lane >> 3, nq = lane & 7; const int v = v0 + 4 * nq;
    const int col = MAP == 0 ? v : (MAP == 1 ? map_in(v) : (MAP == 2 ? map_qb(v) : map_kvb(v)));
    f32x4 x[8];
#pragma unroll
    for (int i = 0; i < 8; ++i) x[i] = (col >= 0) ? *(const f32x4*)(W + (size_t)(k0 + 8 * i + kr) * N + col) : (f32x4){0.f, 0.f, 0.f, 0.f};
#pragma unroll
    for (int i = 0; i < 8; ++i) { const int kk = 8 * i + kr; const float g = gk ? gk[k0 + kk] : 1.0f; LAS float* d = scr + kk * 33 + 4 * nq; d[0] = x[i][0] * g; d[1] = x[i][1] * g; d[2] = x[i][2] * g; d[3] = x[i][3] * g; }
    asm volatile("s_waitcnt lgkmcnt(0)" ::: "memory");
    const int c = lane & 7;
#pragma unroll
    for (int j = 0; j < 4; ++j) { const int n = (lane >> 3) + 8 * j; const LAS float* s = scr + (8 * c) * 33 + n;
        u32x4 o; o.x = pk2(s[0 * 33], s[1 * 33]); o.y = pk2(s[2 * 33], s[3 * 33]); o.z = pk2(s[4 * 33], s[5 * 33]); o.w = pk2(s[6 * 33], s[7 * 33]);
        *(u32x4*)(WT + (size_t)(v0 + n) * K + k0 + 8 * c) = o; }
    asm volatile("s_waitcnt lgkmcnt(0)" ::: "memory");
}

typedef const __attribute__((address_space(1))) float* gcf_t;
constexpr int I_IN = 16 * (NV / 32), I_QB = 6 * 24, I_KVB = 4 * 32, I_BR1 = 8 * 32, I_O = 16 * 32, I_L = I_IN + I_QB + I_KVB + 3 * I_BR1 + I_O;
struct Args {
    gcf_t x, c, ctx, c_ctx, w_mod, b_mod, g_pre, g_post, w_in, sink, g_qa, w_qb, g_kva, w_kvb, conv_w, w_branch, w_o;
    __attribute__((address_space(1))) float* out; __attribute__((address_space(1))) unsigned char* ws;
};

__device__ __forceinline__ void hx_row(const float* xrow, const float* g, const float* mod  , bf16_t* orow, int lane) {
    f32x4 v[4]; float s = 0.f;
#pragma unroll
    for (int j = 0; j < 4; ++j) { v[j] = *(const f32x4*)(xrow + 4 * lane + 256 * j); s += (v[j][0] * v[j][0] + v[j][1] * v[j][1]) + (v[j][2] * v[j][2] + v[j][3] * v[j][3]); }
    const float rstd = __builtin_amdgcn_rsqf(wave_sum(s, lane) * (1.0f / DM) + EPS);
#pragma unroll
    for (int j = 0; j < 4; ++j) { const int c = 4 * lane + 256 * j; const f32x4 gg = *(const f32x4*)(g + c), sh = *(const f32x4*)(mod + c), sc = *(const f32x4*)(mod + 1024 + c);
        f32x4 h;
#pragma unroll
        for (int e = 0; e < 4; ++e) h[e] = v[j][e] * rstd * gg[e] * (1.0f + sc[e]) + sh[e];
        u32x2 w; w.x = pk2(h[0], h[1]); w.y = pk2(h[2], h[3]); *(u32x2*)(orow + c) = w; }
}


__device__ __forceinline__ void p6_pass(const float* xbase, float* dstbase, const bf16_t* obase, bf16_t* hbase, const float* gp, const float* mod, const float* g1, const float* mod1,
                                        const int nrows, const int gw, const int NGW, const int lane) {
    if (gw >= nrows) return;
    f32x4 gpv[4], gtv[4], g1v[4], shv[4], scv[4];
#pragma unroll
    for (int j = 0; j < 4; ++j) { const int c = 4 * lane + 256 * j; gpv[j] = *(const f32x4*)(gp + c); gtv[j] = *(const f32x4*)(mod + 2048 + c);
        if (hbase) { g1v[j] = *(const f32x4*)(g1 + c); shv[j] = *(const f32x4*)(mod1 + c); scv[j] = *(const f32x4*)(mod1 + 1024 + c); } }
    int r = gw; u32x2 ow[4]; f32x4 xv[4];
#pragma unroll
    for (int j = 0; j < 4; ++j) { ow[j] = *(const u32x2*)(obase + (size_t)r * DM + 4 * lane + 256 * j); xv[j] = *(const f32x4*)(xbase + (size_t)r * DM + 4 * lane + 256 * j); }
    for (;;) {
        const int rn = r + NGW; const bool hn = rn < nrows; const int rl = hn ? rn : r;
        u32x2 now_[4]; f32x4 nxv[4];
#pragma unroll
        for (int j = 0; j < 4; ++j) { now_[j] = *(const u32x2*)(obase + (size_t)rl * DM + 4 * lane + 256 * j); nxv[j] = *(const f32x4*)(xbase + (size_t)rl * DM + 4 * lane + 256 * j); }
        float ov[4][4]; float s = 0.f;
#pragma unroll
        for (int j = 0; j < 4; ++j) { ov[j][0] = bflo(ow[j].x); ov[j][1] = bfhi(ow[j].x); ov[j][2] = bflo(ow[j].y); ov[j][3] = bfhi(ow[j].y);
            s += (ov[j][0] * ov[j][0] + ov[j][1] * ov[j][1]) + (ov[j][2] * ov[j][2] + ov[j][3] * ov[j][3]); }
        const float rstd = __builtin_amdgcn_rsqf(wave_sum(s, lane) * (1.0f / DM) + EPS);
        f32x4 x1[4]; float s1 = 0.f;
#pragma unroll
        for (int j = 0; j < 4; ++j) { const int c = 4 * lane + 256 * j;
#pragma unroll
            for (int e = 0; e < 4; ++e) { x1[j][e] = xv[j][e] + gtv[j][e] * (ov[j][e] * rstd * gpv[j][e]); s1 += x1[j][e] * x1[j][e]; }
            *(f32x4*)(dstbase + (size_t)r * DM + c) = x1[j]; }
        if (hbase) {
            const float rstd1 = __builtin_amdgcn_rsqf(wave_sum(s1, lane) * (1.0f / DM) + EPS);
#pragma unroll
            for (int j = 0; j < 4; ++j) { const int c = 4 * lane + 256 * j; f32x4 h;
#pragma unroll
                for (int e = 0; e < 4; ++e) h[e] = x1[j][e] * rstd1 * g1v[j][e] * (1.0f + scv[j][e]) + shv[j][e];
                u32x2 w; w.x = pk2(h[0], h[1]); w.y = pk2(h[2], h[3]); *(u32x2*)(hbase + (size_t)r * DM + c) = w; }
        }
        if (!hn) break;
#pragma unroll
        for (int j = 0; j < 4; ++j) { ow[j] = now_[j]; xv[j] = nxv[j]; }
        r = rn;
    }
}
__device__ __forceinline__ void hx_pass(const float* xbase, bf16_t* hbase, const float* g, const float* mod, const int nrows, const int gw, const int NGW, const int lane) {
    if (gw >= nrows) return;
    f32x4 gv[4], shv[4], scv[4];
#pragma unroll
    for (int j = 0; j < 4; ++j) { const int c = 4 * lane + 256 * j; gv[j] = *(const f32x4*)(g + c); shv[j] = *(const f32x4*)(mod + c); scv[j] = *(const f32x4*)(mod + 1024 + c); }
    int r = gw; f32x4 xv[4];
#pragma unroll
    for (int j = 0; j < 4; ++j) xv[j] = *(const f32x4*)(xbase + (size_t)r * DM + 4 * lane + 256 * j);
    for (;;) {
        const int rn = r + NGW; const bool hn = rn < nrows; const int rl = hn ? rn : r;
        f32x4 nxv[4];
#pragma unroll
        for (int j = 0; j < 4; ++j) nxv[j] = *(const f32x4*)(xbase + (size_t)rl * DM + 4 * lane + 256 * j);
        float s = 0.f;
#pragma unroll
        for (int j = 0; j < 4; ++j) s += (xv[j][0] * xv[j][0] + xv[j][1] * xv[j][1]) + (xv[j][2] * xv[j][2] + xv[j][3] * xv[j][3]);
        const float rstd = __builtin_amdgcn_rsqf(wave_sum(s, lane) * (1.0f / DM) + EPS);
#pragma unroll
        for (int j = 0; j < 4; ++j) { const int c = 4 * lane + 256 * j; f32x4 h;
#pragma unroll
            for (int e = 0; e < 4; ++e) h[e] = xv[j][e] * rstd * gv[j][e] * (1.0f + scv[j][e]) + shv[j][e];
            u32x2 w; w.x = pk2(h[0], h[1]); w.y = pk2(h[2], h[3]); *(u32x2*)(hbase + (size_t)r * DM + c) = w; }
        if (!hn) break;
#pragma unroll
        for (int j = 0; j < 4; ++j) xv[j] = nxv[j];
        r = rn;
    }
}


struct ResidHook {
    unsigned char* ws; int L_, B_, bid, G, wave_s; bool on;
    __device__ __forceinline__ void operator()() const {
        if (!on) return;
        const __attribute__((address_space(4))) Args& a_ = *(const __attribute__((address_space(4))) Args*)__builtin_amdgcn_kernarg_segment_ptr();
        float* MOD = (float*)(ws + WS_MOD); float* CTX1 = (float*)(ws + WS_CTX1); bf16_t* HX = (bf16_t*)(ws + WS_HX); bf16_t* OUTB = (bf16_t*)(ws + WS_PB + B_OUT);
        const bool upd_ = (L_ < DEPTH - 1); const int lane_ = tid_from_wave(wave_s) & 63, gw_ = bid * 8 + wave_s, NGW = G * 8;
        const float* gp_ = (const float*)(a_.g_post + (size_t)L_ * DM); const float* g1_ = upd_ ? (const float*)(a_.g_pre + (size_t)(L_ + 1) * DM) : gp_;
        const float* xlat_ = (L_ == 0 ? (const float*)a_.x : (const float*)a_.out) + (size_t)B_ * SEQ * DM;
        const int ex_ = (33 * (NV / 256)) % G; const int light_ = (ex_ > 0 && G == 256) ? G - ex_ : 0; const int nA_ = SEQ - (light_ > 0 ? (SEQ * 11 / 100) / 4 * 4 : 0);
        p6_pass(xlat_, (float*)a_.out + (size_t)B_ * SEQ * DM, OUTB, upd_ ? HX + (size_t)B_ * RB * DM : nullptr, gp_, MOD + ((size_t)L_ * 3 + B_) * 3072, g1_,
                MOD + ((size_t)(upd_ ? L_ + 1 : L_) * 3 + B_) * 3072, nA_, gw_, NGW, lane_);
        if (light_ > 0 && bid >= G - light_)
            p6_pass(xlat_ + (size_t)nA_ * DM, (float*)a_.out + ((size_t)B_ * SEQ + nA_) * DM, OUTB + (size_t)nA_ * DM, upd_ ? HX + ((size_t)B_ * RB + nA_) * DM : nullptr, gp_, MOD + ((size_t)L_ * 3 + B_) * 3072, g1_,
                    MOD + ((size_t)(upd_ ? L_ + 1 : L_) * 3 + B_) * 3072, SEQ - nA_, (bid - (G - light_)) * 8 + wave_s, light_ * 8, lane_);
        if (upd_) { const float* xc_ = (L_ == 0 ? (const float*)a_.ctx : (const float*)CTX1) + (size_t)B_ * CTX * DM;
            p6_pass(xc_, CTX1 + (size_t)B_ * CTX * DM, OUTB + (size_t)SEQ * DM, HX + ((size_t)B_ * RB + SEQ) * DM, gp_, MOD + ((size_t)L_ * 3 + 2) * 3072, g1_, MOD + ((size_t)(L_ + 1) * 3 + 2) * 3072,
                    CTX, gw_, NGW, lane_); }
    }
};

__global__ void __launch_bounds__(512, 2) fwd_megakernel(Args kargs_unused) {
    extern __shared__ __attribute__((aligned(16))) unsigned char smem[];
    LAS unsigned char* lds = (LAS unsigned char*)smem;
    cg::grid_group grid = cg::this_grid();
#define GSYNC() do { XcdBarrier xb_; xb_.bar = (unsigned*)(OPQ_WS() + WS_BAR); xb_.x = xb_xcc_id(); xb_.st = (volatile LAS unsigned*)(lds + LDS_MISC); xcd_barrier(xb_, wave_s); } while (0)
    const int wave_s = __builtin_amdgcn_readfirstlane(threadIdx.x >> 6);
    const int tid = tid_from_wave(wave_s), lane = tid & 63, wave = wave_s;
    const int G0 = gridDim.x, bid0 = blockIdx.x;
    const int G = G0, bid = bid0;
    const int gw = bid * 8 + wave, NGW = G * 8;
#define KARGS() ({ const __attribute__((address_space(4))) Args* p_ = (const __attribute__((address_space(4))) Args*)__builtin_amdgcn_kernarg_segment_ptr(); asm volatile("" : "+s"(p_)); p_; })
    unsigned char* const ws0 = (unsigned char*)KARGS()->ws;
    if (tid < 64) ((LAS unsigned*)(lds + LDS_MISC))[tid] = 0u;
    __syncthreads();
    if (bid0 == 0) { for (int i = tid; i < (int)(BAR_BYTES / 4); i += 512) ((unsigned*)(ws0 + WS_BAR))[i] = 0u; __threadfence(); }
#define OPQ_WS() ({ __attribute__((address_space(1))) unsigned char* w_ = (__attribute__((address_space(1))) unsigned char*)ws0; asm volatile("" : "+s"(w_)); (unsigned char*)w_; })
#define PHASE_PTRS() int G = G0, bid = bid0; asm volatile("" : "+s"(G), "+s"(bid)); const int NGW = G * 8; (void)NGW; unsigned char* ws = OPQ_WS(); unsigned char* pb = ws + WS_PB; float* MOD = (float*)(ws + WS_MOD); float* CTX1 = (float*)(ws + WS_CTX1); bf16_t* HX = (bf16_t*)(ws + WS_HX); \
    bf16_t *QA = (bf16_t*)(pb + B_QA), *KA = (bf16_t*)(pb + B_KA), *VAT = (bf16_t*)(pb + B_VAT), *QLAT = (bf16_t*)(pb + B_QLAT), *KVLAT = (bf16_t*)(pb + B_KVLAT), \
           *QB = (bf16_t*)(pb + B_QB), *KB = (bf16_t*)(pb + B_KB), *VBT = (bf16_t*)(pb + B_VBT), *YA = (bf16_t*)(pb + B_YA), *YB = (bf16_t*)(pb + B_YB), \
           *PC = (bf16_t*)(pb + B_PC), *ZC = (bf16_t*)(pb + B_ZC), *OUTB = (bf16_t*)(pb + B_OUT), *MB = (bf16_t*)(pb + B_M); \
    (void)MOD; (void)CTX1; (void)HX; (void)QA; (void)KA; (void)VAT; (void)QLAT; (void)KVLAT; (void)QB; (void)KB; (void)VBT; (void)YA; (void)YB; (void)PC; (void)ZC; (void)OUTB; (void)MB;
    if (PH_MASK & 1) {
        PHASE_PTRS();
        const __attribute__((address_space(4))) Args& a = *KARGS();
        LAS float* scr = (LAS float*)(lds + wave * 16384);
#define CONVERT_LAYER(l, w0, nw, i0, i1) do { unsigned char* wl_ = ws + WS_W + (size_t)(l) * W_STRIDE; \
        for (int it = (i0) + (w0); it < (i1); it += (nw)) { int r = it; \
            if (r < I_IN) { transpose_item<1>((const float*)(a.w_in + (size_t)(l) * DM * D_IN), DM, D_IN, (bf16_t*)(wl_ + W_IN), nullptr, scr, r, NV / 32, lane); continue; } r -= I_IN; \
            if (r < I_QB) { transpose_item<2>((const float*)(a.w_qb + (size_t)(l) * QLORA * 768), QLORA, 768, (bf16_t*)(wl_ + W_QB), (const float*)(a.g_qa + (l) * QLORA), scr, r, 24, lane); continue; } r -= I_QB; \
            if (r < I_KVB) { transpose_item<3>((const float*)(a.w_kvb + (size_t)(l) * KVLORA * 1024), KVLORA, 1024, (bf16_t*)(wl_ + W_KVB), (const float*)(a.g_kva + (l) * KVLORA), scr, r, 32, lane); continue; } r -= I_KVB; \
            if (r < 3 * I_BR1) { const int j = r / I_BR1; transpose_item<0>((const float*)(a.w_branch + ((size_t)(l) * 3 + j) * 512 * 1024), 512, 1024, (bf16_t*)(wl_ + W_BR) + (size_t)j * 1024 * 512, nullptr, scr, r % I_BR1, 32, lane); continue; } r -= 3 * I_BR1; \
            transpose_item<0>((const float*)(a.w_o + (size_t)(l) * 1024 * 1024), 1024, 1024, (bf16_t*)(wl_ + W_O), nullptr, scr, r, 32, lane); } } while (0)
        CONVERT_LAYER(0, gw, NGW, 0, I_L);
        __syncthreads();
        LAS float* sv = (LAS float*)lds;
        LAS float* red = (LAS float*)(lds + 12288);
        for (int i = tid; i < 3 * 1024; i += 512) { const int v = i >> 10, k = i & 1023; const float xv = (v < 2) ? a.c[v * 1024 + k] : a.c_ctx[k]; sv[i] = siluf_(xv); }
        __syncthreads();
        for (int it = bid; it < DEPTH * 96; it += G) {
            const int l = it / 96, cq = tid & 7, kg = tid >> 3;
            const float* wp = (const float*)(a.w_mod + (size_t)l * DM * 3072 + (size_t)(kg * 16) * 3072 + (it % 96) * 32 + 4 * cq);
            f32x4 wv[16];
#pragma unroll
            for (int kk = 0; kk < 16; ++kk) wv[kk] = *(const f32x4*)(wp + (size_t)kk * 3072);
            f32x4 a0 = {0.f, 0.f, 0.f, 0.f}, a1 = a0, a2 = a0;
#pragma unroll
            for (int kk = 0; kk < 16; ++kk) { const int k = kg * 16 + kk; a0 += wv[kk] * sv[k]; a1 += wv[kk] * sv[1024 + k]; a2 += wv[kk] * sv[2048 + k]; }
#pragma unroll
            for (int e = 0; e < 4; ++e) { red[(0 * 64 + kg) * 32 + 4 * cq + e] = a0[e]; red[(1 * 64 + kg) * 32 + 4 * cq + e] = a1[e]; red[(2 * 64 + kg) * 32 + 4 * cq + e] = a2[e]; }
            __syncthreads();
            if (tid < 96) { const int v = tid >> 5, cl = tid & 31; float s = 0.f;
#pragma unroll 8
                for (int q = 0; q < 64; ++q) s += red[(v * 64 + q) * 32 + cl];
                const int cc = (it % 96) * 32 + cl; MOD[((size_t)l * 3 + v) * 3072 + cc] = s + a.b_mod[l * 3072 + cc]; }
            __syncthreads();
        }
    }
    grid.sync();
    (void)xcd_barrier_post((unsigned*)(OPQ_WS() + WS_BAR), (volatile LAS unsigned*)(lds + LDS_MISC), wave_s);
    if (PH_MASK & 2) {
        PHASE_PTRS();
        const __attribute__((address_space(4))) Args& a = *KARGS();
        for (int b = 0; b < NBATCH; ++b) {
            hx_pass((const float*)a.x + (size_t)b * SEQ * DM, HX + (size_t)b * RB * DM, (const float*)a.g_pre, MOD + (size_t)b * 3072, SEQ, gw, NGW, lane);
            hx_pass((const float*)a.ctx + (size_t)b * CTX * DM, HX + ((size_t)b * RB + SEQ) * DM, (const float*)a.g_pre, MOD + (size_t)2 * 3072, CTX, gw, NGW, lane);
        }
    }
    GSYNC();

#define FILLER_CONVERT(nbusy, q) do { if (l == 0 && DEPTH > 1) { const int part_ = 2 * b + (q); const int i0_ = (I_L * part_) / 4, i1_ = (I_L * (part_ + 1)) / 4; const int nidle_ = G - (nbusy); \
        if (nidle_ > 0) { if (bid >= (nbusy)) { const __attribute__((address_space(4))) Args& a = *KARGS(); const int lane = tid_from_wave(wave_s) & 63; LAS float* scr = (LAS float*)(lds + wave_s * 16384); \
                              CONVERT_LAYER(1, (bid - (nbusy)) * 8 + wave_s, nidle_ * 8, i0_, i1_); } } \
        else { const __attribute__((address_space(4))) Args& a = *KARGS(); const int lane = tid_from_wave(wave_s) & 63; LAS float* scr = (LAS float*)(lds + wave_s * 16384); CONVERT_LAYER(1, bid * 8 + wave_s, G * 8, i0_, i1_); } } } while (0)
#define RESIDUAL_PASS(L_, B_) do { const bool upd_ = ((L_) < DEPTH - 1); const int lane_ = tid_from_wave(wave_s) & 63, gw_ = bid * 8 + wave_s; const __attribute__((address_space(4))) Args& a_ = *KARGS(); \
        const float* gp_ = (const float*)(a_.g_post + (size_t)(L_) * DM); const float* g1_ = upd_ ? (const float*)(a_.g_pre + (size_t)((L_) + 1) * DM) : gp_; \
        const float* xlat_ = ((L_) == 0 ? (const float*)a_.x : (const float*)a_.out) + (size_t)(B_) * SEQ * DM; \
        p6_pass(xlat_, (float*)a_.out + (size_t)(B_) * SEQ * DM, OUTB, upd_ ? HX + (size_t)(B_) * RB * DM : nullptr, gp_, MOD + ((size_t)(L_) * 3 + (B_)) * 3072, g1_, \
                MOD + ((size_t)(upd_ ? (L_) + 1 : (L_)) * 3 + (B_)) * 3072, SEQ, gw_, NGW, lane_); \
        if (upd_) { const float* xc_ = ((L_) == 0 ? (const float*)a_.ctx : (const float*)CTX1) + (size_t)(B_) * CTX * DM; \
            p6_pass(xc_, CTX1 + (size_t)(B_) * CTX * DM, OUTB + (size_t)SEQ * DM, HX + ((size_t)(B_) * RB + SEQ) * DM, gp_, MOD + ((size_t)(L_) * 3 + 2) * 3072, g1_, MOD + ((size_t)((L_) + 1) * 3 + 2) * 3072, \
                    CTX, gw_, NGW, lane_); } } while (0)
    for (int l = 0; l < DEPTH; ++l) {
        const bool upd = (l < DEPTH - 1);
        const int nMo = upd ? 33 : 32;
        for (int b = 0; b < NBATCH; ++b) {
            if (PH_MASK & 4) {
                PHASE_PTRS(); const unsigned char* wl = ws + WS_W + (size_t)l * W_STRIDE; (void)wl;
                pg8::OrderMN S; S.nM = 33; S.nN = NV / 256; S.nwg = S.nM * S.nN; S.G = G; S.c = bid; S.A = (const char*)(HX + (size_t)b * RB * DM); S.B = (const char*)(wl + W_IN); S.tstep = (size_t)256 * DM * 2;
                EpiInProj E{pb};
                const int ip_ = 2 * l + b - 1;
                ResidHook H{ws, ip_ >= 0 ? (ip_ >> 1) : 0, ip_ >= 0 ? (ip_ & 1) : 0, bid, G, wave_s, ip_ >= 0};
                pg8::gemm_phase(lds, DM, S, E, wave_s, H);
                if (PROBE_INPROJ2) pg8::gemm_phase(lds, DM, S, E, wave_s);
            }
            GSYNC();
            if (PH_MASK & 8) {
                PHASE_PTRS(); const unsigned char* wl = ws + WS_W + (size_t)l * W_STRIDE; (void)wl;
                pg8::OrderMN S; S.nM = 33; S.nN = 3; S.nwg = 99; S.G = G; S.c = bid; S.A = (const char*)QLAT; S.B = (const char*)(wl + W_QB); S.tstep = (size_t)256 * QLORA * 2;
                LAS float* tab = (LAS float*)(lds + 131072);
                EpiUpQ E{pb, tab};
                RstdHook<QLORA, pg8::OrderMN> H{tab, QLAT, &S, wave_s};
                pg8::gemm_phase(lds, QLORA, S, E, wave_s, H);
            }
            if (PH_MASK & 16) {
                PHASE_PTRS(); const unsigned char* wl = ws + WS_W + (size_t)l * W_STRIDE; (void)wl;
                pg8::OrderMN S; S.nM = 33; S.nN = 4; S.nwg = 132; S.G = G; S.c = (bid + G - (99 % G)) % G; S.A = (const char*)KVLAT; S.B = (const char*)(wl + W_KVB); S.tstep = (size_t)256 * KVLORA * 2;
                LAS float* tab = (LAS float*)(lds + 131072 + 8192);
                EpiUpKV E{pb, tab};
                RstdHook<KVLORA, pg8::OrderMN> H{tab, KVLAT, &S, wave_s};
                pg8::gemm_phase(lds, KVLORA, S, E, wave_s, H);
            }
            GSYNC();
            if (PH_MASK & 32) {
                PHASE_PTRS(); const unsigned char* wl = ws + WS_W + (size_t)l * W_STRIDE; (void)wl;
                const __attribute__((address_space(4))) Args& a = *KARGS();
                for (int u = bid; u < 256; u += G) {
                    const int h = u & 7, qb = u >> 3;
                    if (PROBE_MLA2) attn_unit<96, false>(lds, QB + h * 96, 768, KB + h * 96, 768, VBT + (size_t)h * 64 * RB, YB + h * 64, qb * 256, 0, RB / 64, 0, 0, NEG, 0.f, wave_s, G0 == 12345);
                    attn_unit<96, false>(lds, QB + h * 96, 768, KB + h * 96, 768, VBT + (size_t)h * 64 * RB, YB + h * 64, qb * 256, 0, RB / 64, 0, 0, NEG, 0.f, wave_s);
                }
                {
                    unsigned* wq = (unsigned*)(ws + WS_BAR + 14336) + 16 * (2 * l + b);
                    volatile LAS unsigned* slot = (volatile LAS unsigned*)(lds + LDS_MISC + 64);
                    const int n_ctx = upd ? 16 : 0, n_items = 256 + n_ctx + 264;
                    const float* cw = (const float*)(a.conv_w + (size_t)l * 3 * 512);
                    for (;;) {
                        const int tid = tid_from_wave(wave_s);
                        if (tid == 0) *slot = __hip_atomic_fetch_add(wq, 1u, __ATOMIC_RELAXED, __HIP_MEMORY_SCOPE_AGENT);
                        __syncthreads();
                        const int it = (int)*slot;
                        __syncthreads();
                        if (it >= n_items) break;
                        if (it < 256) {
                            const int h = it & 7, qb = it >> 3, q0 = qb * 256;
                            const int ka = (q0 - 128 < 0) ? 0 : q0 - 128, ke = (q0 + 384 > SEQ) ? SEQ : q0 + 384;
                            attn_unit<64, true>(lds, QA + h * 64, 512, KA + (h >> 2) * 64, 128, VAT + (size_t)(h >> 2) * 64 * RB, YA + h * 64, q0, ka, (ke - ka) / 64, SEQ, CTX / 64,
                                                a.sink[l * 8 + h] * LOG2E, 1.0f, wave_s);
                        } else if (it < 256 + n_ctx) {
                            const int u = it - 256, h = u & 7;
                            if (u < 8) attn_unit<96, false>(lds, QB + h * 96, 768, KB + h * 96, 768, VBT + (size_t)h * 64 * RB, YB + h * 64, SEQ, SEQ, CTX / 64, 0, 0, NEG, 0.f, wave_s);
                            else attn_unit<64, true>(lds, QA + h * 64, 512, KA + (h >> 2) * 64, 128, VAT + (size_t)(h >> 2) * 64 * RB, YA + h * 64, SEQ, SEQ, CTX / 64, 0, 0,
                                                     a.sink[l * 8 + h] * LOG2E, 1.0f, wave_s);
                        } else {
                            const int c0 = (it - 256 - n_ctx) * 2048;
#pragma unroll 1
                            for (int k = 0; k < 4; ++k) {
                                const int i = c0 + k * 512 + tid; if (i >= RB * 64) break;
                                const int row = i >> 6, ch = (i & 63) * 8;
                                const bool has_p = (row != 0) && (row != SEQ), has_n = (row != SEQ - 1) && (row != RB - 1);
                                const u32x4 zc = *(const u32x4*)(ZC + (size_t)row * 512 + ch);
                                const u32x4 zp = has_p ? *(const u32x4*)(ZC + (size_t)(row - 1) * 512 + ch) : (u32x4){0u, 0u, 0u, 0u};
                                const u32x4 zn = has_n ? *(const u32x4*)(ZC + (size_t)(row + 1) * 512 + ch) : (u32x4){0u, 0u, 0u, 0u};
                                const u32x4 pp = *(const u32x4*)(PC + (size_t)row * 512 + ch);
                                const f32x4 w0a = *(const f32x4*)(cw + ch), w0b = *(const f32x4*)(cw + ch + 4), w1a = *(const f32x4*)(cw + 512 + ch), w1b = *(const f32x4*)(cw + 512 + ch + 4),
                                            w2a = *(const f32x4*)(cw + 1024 + ch), w2b = *(const f32x4*)(cw + 1024 + ch + 4);
                                float y[8];
                                const unsigned zpw[4] = {zp.x, zp.y, zp.z, zp.w}, zcw[4] = {zc.x, zc.y, zc.z, zc.w}, znw[4] = {zn.x, zn.y, zn.z, zn.w}, ppw[4] = {pp.x, pp.y, pp.z, pp.w};
#pragma unroll
                                for (int e = 0; e < 4; ++e) {
                                    const float w0l = e < 2 ? w0a[2 * e] : w0b[2 * e - 4], w0h = e < 2 ? w0a[2 * e + 1] : w0b[2 * e - 3];
                                    const float w1l = e < 2 ? w1a[2 * e] : w1b[2 * e - 4], w1h = e < 2 ? w1a[2 * e + 1] : w1b[2 * e - 3];
                                    const float w2l = e < 2 ? w2a[2 * e] : w2b[2 * e - 4], w2h = e < 2 ? w2a[2 * e + 1] : w2b[2 * e - 3];
                                    y[2 * e] = bflo(ppw[e]) * (w0l * bflo(zpw[e]) + w1l * bflo(zcw[e]) + w2l * bflo(znw[e]));
                                    y[2 * e + 1] = bfhi(ppw[e]) * (w0h * bfhi(zpw[e]) + w1h * bfhi(zcw[e]) + w2h * bfhi(znw[e]));
                                }
                                *(u32x4*)(PC + (size_t)row * 512 + ch) = (u32x4){pk2(y[0], y[1]), pk2(y[2], y[3]), pk2(y[4], y[5]), pk2(y[6], y[7])};
                            }
                        }
                    }
                }
            }
            GSYNC();
            if (PH_MASK & 64) {
                PHASE_PTRS(); const unsigned char* wl = ws + WS_W + (size_t)l * W_STRIDE; (void)wl;
                pg8::OrderMerge S; S.nN = 4; S.ngrp = nMo * 4; S.G = G; S.c = bid; S.A0 = (const char*)YA; S.astride = (size_t)RB * 512 * 2; S.B0 = (const char*)(wl + W_BR); S.bstride = (size_t)1024 * 512 * 2;
                S.tstep = (size_t)256 * 512 * 2;
                if (nMo == 32) { S.nN = 8; S.ngrp = nMo * 8; S.tstepB = (size_t)128 * 512 * 2; EpiMerge E{pb, 1}; pg8::gemm_phase<1, true>(lds, 512, S, E, wave_s); }
                else { EpiMerge E{pb, 2}; pg8::gemm_phase<2, true>(lds, 512, S, E, wave_s); }
                FILLER_CONVERT(S.ngrp, 0);
            }
            GSYNC();
            if (PH_MASK & 128) {
                PHASE_PTRS(); const unsigned char* wl = ws + WS_W + (size_t)l * W_STRIDE; (void)wl;
                pg8::OrderMN S; S.nM = nMo; S.nN = 4; S.nwg = nMo * 4; S.G = G; S.c = bid; S.A = (const char*)MB; S.B = (const char*)(wl + W_O); S.tstep = (size_t)256 * DM * 2;
                if (nMo == 32) { S.nN = 8; S.nwg = nMo * 8; S.tstepB = (size_t)128 * DM * 2; EpiOut E{OUTB, 1}; pg8::gemm_phase<1>(lds, DM, S, E, wave_s); }
                else { EpiOut E{OUTB, 2}; pg8::gemm_phase<2>(lds, DM, S, E, wave_s); }
                FILLER_CONVERT(S.nwg, 1);
            }
            GSYNC();
        }
    }
    { PHASE_PTRS(); RESIDUAL_PASS(DEPTH - 1, NBATCH - 1); }
}

extern "C" void kernel_launch(void* const* d_in, const int* in_sizes, int n_in, void* d_out, int out_size, void* d_ws, size_t ws_size, hipStream_t stream) {
    static int grid_blocks = 0;
    if (grid_blocks == 0) {
        if (n_in != 17 || ws_size < WS_END) { fprintf(stderr, "kernel_launch: unexpected inputs (n_in %d, ws %zu < %zu)\n", n_in, ws_size, (size_t)WS_END); grid_blocks = -1; return; }
        int dev = 0, cus = 0, per_cu = 0;
        hipGetDevice(&dev);
        hipDeviceGetAttribute(&cus, hipDeviceAttributeMultiprocessorCount, dev);
        if (hipFuncSetAttribute((const void*)fwd_megakernel, hipFuncAttributeMaxDynamicSharedMemorySize, LDS_BYTES) != hipSuccess) { fprintf(stderr, "kernel_launch: hipFuncSetAttribute failed\n"); grid_blocks = -1; return; }
        if (hipOccupancyMaxActiveBlocksPerMultiprocessor(&per_cu, (const void*)fwd_megakernel, 512, LDS_BYTES) != hipSuccess || per_cu < 1) { fprintf(stderr, "kernel_launch: occupancy query says %d\n", per_cu); per_cu = 1; }
        (void)hipGetLastError();
        grid_blocks = cus * 1;
    }
    if (grid_blocks < 0) return;
    Args a{};
    a.x = (gcf_t)d_in[0]; a.c = (gcf_t)d_in[1]; a.ctx = (gcf_t)d_in[2]; a.c_ctx = (gcf_t)d_in[3]; a.w_mod = (gcf_t)d_in[4]; a.b_mod = (gcf_t)d_in[5];
    a.g_pre = (gcf_t)d_in[6]; a.g_post = (gcf_t)d_in[7]; a.w_in = (gcf_t)d_in[8]; a.sink = (gcf_t)d_in[9]; a.g_qa = (gcf_t)d_in[10]; a.w_qb = (gcf_t)d_in[11];
    a.g_kva = (gcf_t)d_in[12]; a.w_kvb = (gcf_t)d_in[13]; a.conv_w = (gcf_t)d_in[14]; a.w_branch = (gcf_t)d_in[15]; a.w_o = (gcf_t)d_in[16];
    a.out = (__attribute__((address_space(1))) float*)d_out; a.ws = (__attribute__((address_space(1))) unsigned char*)d_ws;
    void* args[] = {&a};
    hipError_t e = hipLaunchCooperativeKernel((const void*)fwd_megakernel, dim3(grid_blocks), dim3(512), args, LDS_BYTES, stream);
    if (e != hipSuccess) fprintf(stderr, "cooperative launch failed: %s (grid %d)\n", hipGetErrorString(e), grid_blocks);
}
```

```cpp
#include <hip/hip_runtime.h>
#include <hip/hip_cooperative_groups.h>
#include <cstdint>
#include <cstdio>
namespace cg = cooperative_groups;

#define LAS __attribute__((address_space(3)))
typedef unsigned short bf16_t;
typedef short bf16x8 __attribute__((ext_vector_type(8)));
typedef float f32x4 __attribute__((ext_vector_type(4)));
typedef float f32x16 __attribute__((ext_vector_type(16)));
typedef unsigned u32x4 __attribute__((ext_vector_type(4)));
typedef unsigned u32x2 __attribute__((ext_vector_type(2)));
typedef float f32x2_t __attribute__((ext_vector_type(2)));
typedef __bf16 bf16x2_t __attribute__((ext_vector_type(2)));

constexpr int DM = 1024, NBATCH = 2, SEQ = 8192, CTX = 256, RB = SEQ + CTX  , RT = NBATCH * RB, DEPTH = 2;
constexpr int D_IN = 7584, NV = 7680;
constexpr int QLORA = 384, KVLORA = 256;
constexpr float EPS = 1e-6f, NEG = -1e30f, LOG2E = 1.4426950408889634f;
constexpr float QS_A = 0.125f * LOG2E;
constexpr float QS_B = 0.10206207261596577f * LOG2E;
constexpr float L2_10000 = 13.287712379549449f;

constexpr size_t MiB = 1u << 20;
constexpr size_t WS_MOD = 0;
constexpr size_t WS_BAR = 3 * MiB, BAR_BYTES = 16384;
constexpr size_t WS_CTX1 = 1 * MiB;
constexpr size_t WS_W = 4 * MiB, W_STRIDE = 22 * MiB;
constexpr size_t W_IN = 0, W_QB = W_IN + (size_t)NV * DM * 2, W_KVB = W_QB + (size_t)768 * QLORA * 2, W_BR = W_KVB + (size_t)1024 * KVLORA * 2,
                 W_O = W_BR + (size_t)3 * 1024 * 512 * 2, W_END = W_O + (size_t)1024 * 1024 * 2;
static_assert(W_END <= W_STRIDE, "weights");
constexpr size_t WS_HX = WS_W + 2 * W_STRIDE;
constexpr size_t WS_PB = WS_HX + (size_t)RT * DM * 2;
constexpr size_t B_QA = 0, B_KA = B_QA + (size_t)RB * 512 * 2, B_VAT = B_KA + (size_t)RB * 128 * 2, B_QLAT = B_VAT + (size_t)RB * 128 * 2,
                 B_KVLAT = B_QLAT + (size_t)RB * 384 * 2, B_QB = B_KVLAT + (size_t)RB * 256 * 2, B_KB = B_QB + (size_t)RB * 768 * 2,
                 B_VBT = B_KB + (size_t)RB * 768 * 2, B_YA = B_VBT + (size_t)RB * 512 * 2, B_YB = B_YA + (size_t)RB * 512 * 2,
                 B_PC = B_YB + (size_t)RB * 512 * 2, B_ZC = B_PC + (size_t)RB * 512 * 2, B_G = B_ZC + (size_t)RB * 512 * 2,
                 B_END = B_G + (size_t)RB * 3072 * 2;
constexpr size_t B_OUT = B_END;
constexpr size_t B_M = B_QB;
static_assert(B_M + (size_t)RB * 1024 * 2 <= B_VBT, "overlays");
constexpr size_t WS_END = WS_PB + B_OUT + (size_t)RB * 1024 * 2;
static_assert(WS_END <= 256 * MiB, "workspace");

constexpr int LDS_BYTES = 147456 + 256, LDS_MISC = 147456;
#ifndef PH_MASK
#define PH_MASK 0xFFFF
#endif
#ifndef PROBE_MLA2
#define PROBE_MLA2 0
#endif
#ifndef PROBE_INPROJ2
#define PROBE_INPROJ2 0
#endif
#ifndef PROBE_SYNC2
#define PROBE_SYNC2 0
#endif

__device__ __forceinline__ unsigned pk2(float lo, float hi) { f32x2_t v = {lo, hi}; bf16x2_t b = __builtin_convertvector(v, bf16x2_t); return __builtin_bit_cast(unsigned, b); }
__device__ __forceinline__ float bflo(unsigned w) { return __uint_as_float(w << 16); }
__device__ __forceinline__ float bfhi(unsigned w) { return __uint_as_float(w & 0xffff0000u); }
__device__ __forceinline__ float fexp2(float x) { return __builtin_amdgcn_exp2f(x); }
__device__ __forceinline__ float sigmoidf_(float x) { return __builtin_amdgcn_rcpf(1.0f + fexp2(-x * LOG2E)); }
__device__ __forceinline__ float siluf_(float x) { return x * sigmoidf_(x); }
__device__ __forceinline__ u32x4 pack8(f32x4 a, f32x4 b) { u32x4 w; w.x = pk2(a[0], a[1]); w.y = pk2(a[2], a[3]); w.z = pk2(b[0], b[1]); w.w = pk2(b[2], b[3]); return w; }
__device__ __forceinline__ int tid_from_wave(int wave_s) { int t; asm volatile("v_mbcnt_lo_u32_b32 %0, -1, 0\n\tv_mbcnt_hi_u32_b32 %0, -1, %0" : "=v"(t)); return t + wave_s * 64; }
__device__ __forceinline__ float shx(float v, int o, int lane) { return __builtin_bit_cast(float, __builtin_amdgcn_ds_bpermute((lane ^ o) << 2, __builtin_bit_cast(int, v))); }
__device__ __forceinline__ float wave_sum(float v, int lane) {
#pragma unroll
    for (int o = 1; o < 64; o <<= 1) v += shx(v, o, lane);
    return v;
}

namespace pg8 {
constexpr int BM = 256, BK = 64, HALF = 128, HTB = HALF * BK * 2, STAGE_BYTES = 8 * HTB, NXCD = 8, WGM = 8;
__host__ __device__ __forceinline__ int lds_byte(int r, int c) { const int st = (r >> 4) * 2 + (c >> 5), rr = r & 15, cc = c & 31, ob = rr * 64 + cc * 2; return st * 1024 + (ob ^ (((ob >> 9) & 1) << 5)); }
__host__ __device__ __forceinline__ void stage_rc(int b, int& R, int& C) { const int st = b / 1024, sb = b % 1024, swz = sb ^ (((sb >> 9) & 1) << 5); R = (st >> 1) * 16 + swz / 64; C = (st & 1) * 32 + (swz % 64) / 2; }
__host__ __device__ __forceinline__ int perm32(int rho) { const int n = rho >> 4, i = rho & 15; return 8 * (i >> 2) + 4 * n + (i & 3); }

struct Unit { const char* A; const char* B; int pm, pn, aux; };

struct OrderMN {
    int nM, nN, nwg, G, c; const char* A; const char* B; size_t tstep; size_t tstepB = 0;
    __device__ __forceinline__ bool next(int i, Unit& u) const {
        const long L = (long)i * G + c; if (L >= nwg) return false;
        int wgid = (int)L; { const int q = nwg / NXCD, r = nwg % NXCD, xcd = wgid % NXCD, off = wgid / NXCD; wgid = (xcd < r ? xcd * (q + 1) : r * (q + 1) + (xcd - r) * q) + off; }
        const int nig = WGM * nN, gid = wgid / nig, fm = gid * WGM, gsz = (nM - fm) < WGM ? (nM - fm) : WGM;
        u.pm = fm + ((wgid % nig) % gsz); u.pn = (wgid % nig) / gsz; u.aux = i;
        u.A = A + (size_t)u.pm * tstep; u.B = B + (size_t)u.pn * (tstepB ? tstepB : tstep); return true;
    }
};
struct OrderMerge {
    int ngrp, nN, G, c; const char* A0; size_t astride; const char* B0; size_t bstride; size_t tstep; size_t tstepB = 0;
    __device__ __forceinline__ bool next(int i, Unit& u) const {
        const int grp = c + (i / 3) * G; if (grp >= ngrp) return false;
        const int j = i % 3; u.pm = grp / nN; u.pn = grp % nN; u.aux = j;
        u.A = A0 + (size_t)j * astride + (size_t)u.pm * tstep; u.B = B0 + (size_t)j * bstride + (size_t)u.pn * (tstepB ? tstepB : tstep); return true;
    }
};

struct NoPre { __device__ __forceinline__ void operator()() const {} };
template <int NH = 2, bool CHAIN = false, class Epi, class Sched, class Pre = NoPre>
__device__ __forceinline__ void gemm_phase(LAS unsigned char* lds, const int K, const Sched& S, const Epi& E, const int wave_s, const Pre& pre = Pre()) {
    const int tid = tid_from_wave(wave_s);
    const int wid = __builtin_amdgcn_readfirstlane(tid >> 6), lane = tid & 63, wr = wid >> 2, wc = wid & 3, fr = lane & 15, fq = lane >> 4;
    const int nt = K / BK;
    unsigned voffA[2], voffB[2];
#pragma unroll
    for (int i = 0; i < 2; ++i) { int R, C; stage_rc(tid * 16 + i * 8192, R, C); const int Rb = (R & ~31) + perm32(R & 31);
        voffA[i] = (unsigned)(R * K + C) * 2u; voffB[i] = (unsigned)(Rb * K + C) * 2u; }
    const size_t kstep = (size_t)(BK * 2);
    const size_t hstep = (size_t)HALF * K * 2;
    const unsigned ldsw = (unsigned)wid * 1024u;
    const int aoff = lds_byte(wr * 64 + fr, fq * 8), boff = lds_byte(wc * 32 + fr, fq * 8);
#define PG8_SA(b, h) (((b) * 2 + (h)) * HTB)
#define PG8_SB(b, h) ((4 + (b) * 2 + (h)) * HTB)
#define PG8_STAGE(bufoff, gbase, voff) do { _Pragma("unroll") for (int _i = 0; _i < 2; ++_i) \
        __builtin_amdgcn_global_load_lds((const unsigned*)((const char*)(gbase) + (voff)[_i]), (LAS unsigned*)(lds + (bufoff) + ldsw + _i * 8192), 16, 0, 0); } while (0)
#define PG8_LDA(dst, b, h) do { _Pragma("unroll") for (int m = 0; m < 4; ++m) _Pragma("unroll") for (int k = 0; k < 2; ++k) dst[m][k] = *(const LAS bf16x8*)(lds + PG8_SA(b, h) + aoff + m * 2048 + k * 1024); } while (0)
#define PG8_LDB(dst, b, h) do { _Pragma("unroll") for (int n = 0; n < 2; ++n) _Pragma("unroll") for (int k = 0; k < 2; ++k) dst[n][k] = *(const LAS bf16x8*)(lds + PG8_SB(b, h) + boff + n * 2048 + k * 1024); } while (0)
#define PG8_MMA(ai, bj, At, Bt) do { __builtin_amdgcn_s_setprio(1); _Pragma("unroll") for (int m = 0; m < 4; ++m) _Pragma("unroll") for (int n = 0; n < 2; ++n) _Pragma("unroll") for (int k = 0; k < 2; ++k) \
        acc[ai][bj][m][n] = __builtin_amdgcn_mfma_f32_16x16x32_bf16(Bt[n][k], At[m][k], acc[ai][bj][m][n], 0, 0, 0); __builtin_amdgcn_s_setprio(0); } while (0)
#define PG8_WAIT_V(n) asm volatile("s_waitcnt vmcnt(" #n ")" ::: "memory")
#define PG8_WAIT_L(n) asm volatile("s_waitcnt lgkmcnt(" #n ")" ::: "memory")
#define PG8_BAR __builtin_amdgcn_s_barrier()
#define PG8_SCHED __builtin_amdgcn_sched_barrier(0)
    Unit cur, nxt; int ui = 0;
    if (!S.next(0, cur)) return;
    f32x4 acc[2][2][4][2];
#pragma unroll
    for (int a = 0; a < 2; ++a)
#pragma unroll
        for (int b = 0; b < 2; ++b)
#pragma unroll
            for (int m = 0; m < 4; ++m)
#pragma unroll
                for (int n = 0; n < 2; ++n) acc[a][b][m][n] = (f32x4){0.f, 0.f, 0.f, 0.f};
    bf16x8 At[4][2], B0[2][2], B1[2][2];
    const char* cA = cur.A; const char* cB = cur.B;
#define PG8_WAIT_STEADY() do { if constexpr (NH == 2) PG8_WAIT_V(8); else PG8_WAIT_V(6); } while (0)
    PG8_STAGE(PG8_SB(0, 0), cB, voffB); if constexpr (NH == 2) PG8_STAGE(PG8_SB(0, 1), cB + hstep, voffB); PG8_STAGE(PG8_SA(0, 0), cA, voffA); PG8_STAGE(PG8_SA(0, 1), cA + hstep, voffA);
    pre();
    if (wr == 1) PG8_BAR;
    PG8_WAIT_V(2); PG8_BAR;
    PG8_STAGE(PG8_SB(1, 0), cB + kstep, voffB); PG8_STAGE(PG8_SA(1, 0), cA + kstep, voffA); if constexpr (NH == 2) PG8_STAGE(PG8_SB(1, 1), cB + hstep + kstep, voffB);
    if constexpr (NH == 2) PG8_WAIT_V(6); else PG8_WAIT_V(4);
    PG8_BAR;
    for (;;) {
        const bool has_next = S.next(ui + 1, nxt);
        const char* nA = has_next ? nxt.A : cA; const char* nB = has_next ? nxt.B : cB;
        for (int t = 0; t < nt; t += 2) {
            const bool last = (t == nt - 2);
            const char* a1 = cA + (size_t)(t + 1) * kstep;
            const char* a2 = last ? nA : cA + (size_t)(t + 2) * kstep; const char* b2 = last ? nB : cB + (size_t)(t + 2) * kstep;
            const char* a3 = a2 + kstep; const char* b3 = b2 + kstep;
            PG8_LDB(B0, 0, 0); if constexpr (NH == 2) PG8_LDB(B1, 0, 1); PG8_SCHED; PG8_LDA(At, 0, 0); PG8_STAGE(PG8_SA(1, 1), a1 + hstep, voffA);
            PG8_WAIT_STEADY(); PG8_WAIT_L(0); PG8_BAR; PG8_MMA(0, 0, At, B0); if constexpr (NH == 2) PG8_MMA(0, 1, At, B1); PG8_BAR; PG8_SCHED;
            PG8_LDA(At, 0, 1); PG8_STAGE(PG8_SB(0, 0), b2, voffB); if constexpr (NH == 2) PG8_STAGE(PG8_SB(0, 1), b2 + hstep, voffB); PG8_STAGE(PG8_SA(0, 0), a2, voffA);
            PG8_WAIT_STEADY(); PG8_WAIT_L(0); PG8_BAR; PG8_MMA(1, 0, At, B0); if constexpr (NH == 2) PG8_MMA(1, 1, At, B1); PG8_BAR; PG8_SCHED;
            PG8_LDB(B0, 1, 0); if constexpr (NH == 2) PG8_LDB(B1, 1, 1); PG8_SCHED; PG8_LDA(At, 1, 0); PG8_STAGE(PG8_SA(0, 1), a2 + hstep, voffA);
            PG8_WAIT_STEADY(); PG8_WAIT_L(0); PG8_BAR; PG8_MMA(0, 0, At, B0); if constexpr (NH == 2) PG8_MMA(0, 1, At, B1); PG8_BAR; PG8_SCHED;
            PG8_LDA(At, 1, 1); PG8_STAGE(PG8_SB(1, 0), b3, voffB); if constexpr (NH == 2) PG8_STAGE(PG8_SB(1, 1), b3 + hstep, voffB); PG8_STAGE(PG8_SA(1, 0), a3, voffA);
            PG8_WAIT_STEADY(); PG8_WAIT_L(0); PG8_BAR; PG8_MMA(1, 0, At, B0); if constexpr (NH == 2) PG8_MMA(1, 1, At, B1); PG8_BAR; PG8_SCHED;
        }
        if (wr == 0) PG8_BAR;
        bool chained = false;
        { const int l2_ = tid_from_wave(wave_s) & 63; const int fr_ = l2_ & 15, fq_ = l2_ >> 4;
          if constexpr (CHAIN) { if (cur.aux < 2) { E.mid(acc, cur, wr, wc, fr_, fq_); chained = true; } else E(acc, cur, wr, wc, fr_, fq_); }
          else E(acc, cur, wr, wc, fr_, fq_); }
        if (!has_next) break;
        if (!chained)
#pragma unroll
        for (int a = 0; a < 2; ++a)
#pragma unroll
            for (int b = 0; b < 2; ++b)
#pragma unroll
                for (int m = 0; m < 4; ++m)
#pragma unroll
                    for (int n = 0; n < 2; ++n) acc[a][b][m][n] = (f32x4){0.f, 0.f, 0.f, 0.f};
        cur = nxt; cA = nA; cB = nB; ++ui;
        if (wr == 1) PG8_BAR;
    }
    PG8_WAIT_V(0);
    PG8_BAR;
#undef PG8_SA
#undef PG8_SB
#undef PG8_STAGE
#undef PG8_LDA
#undef PG8_LDB
#undef PG8_MMA
#undef PG8_WAIT_STEADY
#undef PG8_WAIT_V
#undef PG8_WAIT_L
#undef PG8_BAR
#undef PG8_SCHED
}
}
using pg8::Unit;

#define INVA_LIST {1.0f, 0.5623413251903491f, 0.31622776601683794f, 0.1778279410038923f, 0.1f, 0.05623413251903491f, 0.03162277660168379f, 0.01778279410038923f, \
                   0.01f, 0.005623413251903491f, 0.0031622776601683794f, 0.0017782794100389228f, 0.001f, 0.0005623413251903491f, 0.00031622776601683794f, 0.00017782794100389227f}
#define INVB_LIST {1.0f, 0.31622776601683794f, 0.1f, 0.03162277660168379f, 0.01f, 0.0031622776601683794f, 0.001f, 0.00031622776601683794f}
__device__ __forceinline__ void rope_cs(float p, float inv, float& c, float& s) { const float a = p * inv; c = __cosf(a); s = __sinf(a); }

struct EpiInProj {
    unsigned char* pb;
    __device__ __forceinline__ void operator()(const f32x4 (&acc)[2][2][4][2], const Unit& u, int wr, int wc, int fr, int fq) const {
        const int pn = u.pn;
        bf16_t *QA = (bf16_t*)(pb + B_QA), *KA = (bf16_t*)(pb + B_KA), *VAT = (bf16_t*)(pb + B_VAT), *QLAT = (bf16_t*)(pb + B_QLAT), *KVLAT = (bf16_t*)(pb + B_KVLAT),
               *KB = (bf16_t*)(pb + B_KB), *YA = (bf16_t*)(pb + B_YA), *YB = (bf16_t*)(pb + B_YB), *PC = (bf16_t*)(pb + B_PC), *ZC = (bf16_t*)(pb + B_ZC), *G = (bf16_t*)(pb + B_G);
#pragma unroll
        for (int ai = 0; ai < 2; ++ai)
#pragma unroll
            for (int m = 0; m < 4; ++m) {
                const int row = u.pm * 256 + ai * 128 + wr * 64 + m * 16 + fr;
                const bool lat = row < SEQ; const float prow = (float)(row >> 6), pcol = (float)(row & 63);
                if (pn <= 2) {
                    if (pn < 2 || wc < 2) {
                        f32x4 o1[2], o2[2];
                        const float p = (fq < 2) ? prow : pcol;
#pragma unroll
                        for (int n = 0; n < 2; ++n)
#pragma unroll
                            for (int j = 0; j < 4; ++j) {
                                constexpr float IA[16] = INVA_LIST; float c = 1.f, s = 0.f;
                                if (lat) rope_cs(p, (fq & 1) ? IA[8 + 4 * n + j] : IA[4 * n + j], c, s);
                                const float x1 = acc[ai][0][m][n][j], x2 = acc[ai][1][m][n][j];
                                o1[n][j] = x1 * c - x2 * s; o2[n][j] = x2 * c + x1 * s;
                            }
                        if (pn < 2) {
                            const int head = 4 * pn + wc; bf16_t* dst = QA + (size_t)row * 512 + head * 64 + 8 * fq;
                            *(u32x4*)dst = pack8(o1[0] * QS_A, o1[1] * QS_A); *(u32x4*)(dst + 32) = pack8(o2[0] * QS_A, o2[1] * QS_A);
                        } else {
                            bf16_t* dst = KA + (size_t)row * 128 + wc * 64 + 8 * fq;
                            *(u32x4*)dst = pack8(o1[0], o1[1]); *(u32x4*)(dst + 32) = pack8(o2[0], o2[1]);
                        }
                    } else {
#pragma unroll
                        for (int bj = 0; bj < 2; ++bj)
#pragma unroll
                            for (int n = 0; n < 2; ++n)
#pragma unroll
                                for (int j = 0; j < 4; ++j) { const int d = (wc - 2) * 32 + 8 * fq + 4 * n + j;
                                    VAT[(size_t)(bj * 64 + d) * RB + row] = (bf16_t)(pk2(acc[ai][bj][m][n][j], 0.f) & 0xffffu); }
                    }
                } else if (pn <= 4 || pn == 8 || pn == 9) {
                    bf16_t* Y = (pn <= 4) ? YA : YB; const int t = (pn <= 4) ? pn - 3 : pn - 8;
#pragma unroll
                    for (int bj = 0; bj < 2; ++bj) { f32x4 a = acc[ai][bj][m][0], b = acc[ai][bj][m][1];
#pragma unroll
                        for (int j = 0; j < 4; ++j) { a[j] = siluf_(a[j]); b[j] = siluf_(b[j]); }
                        *(u32x4*)(Y + (size_t)row * 512 + t * 256 + bj * 128 + wc * 32 + 8 * fq) = pack8(a, b); }
                } else if (pn <= 7) {
#pragma unroll
                    for (int bj = 0; bj < 2; ++bj) {
                        const int lv = (pn - 5) * 256 + bj * 128 + wc * 32 + 8 * fq;
                        if (lv < 384) *(u32x4*)(QLAT + (size_t)row * 384 + lv) = pack8(acc[ai][bj][m][0], acc[ai][bj][m][1]);
                        else if (lv < 640) *(u32x4*)(KVLAT + (size_t)row * 256 + (lv - 384)) = pack8(acc[ai][bj][m][0], acc[ai][bj][m][1]);
                        else if (pn == 7 && bj == 1 && wc == 0) {
                            f32x4 o[2]; const float p = (fq & 1) ? pcol : prow;
#pragma unroll
                            for (int n = 0; n < 2; ++n)
#pragma unroll
                                for (int j = 0; j < 4; ++j) {
                                    const float mine = acc[ai][bj][m][n][j]; const float partner = shx(mine, 32, fr + 16 * fq);
                                    constexpr float IB[8] = INVB_LIST; float c = 1.f, s = 0.f; if (lat) rope_cs(p, IB[4 * n + j], c, s);
                                    o[n][j] = mine * c + ((fq < 2) ? -partner : partner) * s;
                                }
                            const u32x4 w = pack8(o[0], o[1]);
#pragma unroll
                            for (int h = 0; h < 8; ++h) *(u32x4*)(KB + (size_t)row * 768 + h * 96 + 64 + 8 * fq) = w;
                        }
                    }
                } else if (pn <= 17) {
                    const int ch = (pn - 10) * 64 + wc * 16 + fq * 4;
                    const f32x4 bc = acc[ai][0][m][0], cc = acc[ai][0][m][1], uc = acc[ai][1][m][0], zc = acc[ai][1][m][1];
                    f32x4 pv, zv;
#pragma unroll
                    for (int j = 0; j < 4; ++j) { pv[j] = bc[j] * siluf_(zc[j]); zv[j] = cc[j] * uc[j]; }
                    u32x2 pw, zw; pw.x = pk2(pv[0], pv[1]); pw.y = pk2(pv[2], pv[3]); zw.x = pk2(zv[0], zv[1]); zw.y = pk2(zv[2], zv[3]);
                    *(u32x2*)(PC + (size_t)row * 512 + ch) = pw; *(u32x2*)(ZC + (size_t)row * 512 + ch) = zw;
                } else {
#pragma unroll
                    for (int bj = 0; bj < 2; ++bj) { f32x4 a = acc[ai][bj][m][0], b = acc[ai][bj][m][1];
#pragma unroll
                        for (int j = 0; j < 4; ++j) { a[j] = sigmoidf_(a[j]); b[j] = sigmoidf_(b[j]); }
                        *(u32x4*)(G + (size_t)row * 3072 + (pn - 18) * 256 + bj * 128 + wc * 32 + 8 * fq) = pack8(a, b); }
                }
                asm volatile("" ::: "memory");
            }
    }
};

template <int NC, class Sched> __device__ __forceinline__ void rstd_table(LAS float* tab, const bf16_t* X, const Sched& S, const int wave_s) {
    const int tid = tid_from_wave(wave_s);
    for (int i = 0; i < 8; ++i) { Unit u; if (!S.next(i, u)) break;
        const bf16_t* rp = X + (size_t)(u.pm * 256 + (tid >> 1)) * NC + (tid & 1) * (NC / 2); float s = 0.f;
#pragma unroll
        for (int c = 0; c < NC / 16; ++c) { const u32x4 w = *(const u32x4*)(rp + c * 8);
            const float a0 = bflo(w.x), a1 = bfhi(w.x), a2 = bflo(w.y), a3 = bfhi(w.y), a4 = bflo(w.z), a5 = bfhi(w.z), a6 = bflo(w.w), a7 = bfhi(w.w);
            s += (a0 * a0 + a1 * a1) + (a2 * a2 + a3 * a3) + (a4 * a4 + a5 * a5) + (a6 * a6 + a7 * a7); }
        s += shx(s, 1, tid & 63);
        if ((tid & 1) == 0) tab[i * 256 + (tid >> 1)] = __builtin_amdgcn_rsqf(s * (1.0f / NC) + EPS);
    }
    __syncthreads();
}

template <int NC, class Sched> struct RstdHook { LAS float* tab; const bf16_t* X; const Sched* S; int wave_s;
    __device__ __forceinline__ void operator()() const { rstd_table<NC>(tab, X, *S, wave_s); } };

struct EpiUpQ {
    unsigned char* pb; const LAS float* tab;
    __device__ __forceinline__ void operator()(const f32x4 (&acc)[2][2][4][2], const Unit& u, int wr, int wc, int fr, int fq) const {
        const int pn = u.pn; bf16_t* QB = (bf16_t*)(pb + B_QB);
#pragma unroll
        for (int ai = 0; ai < 2; ++ai)
#pragma unroll
            for (int m = 0; m < 4; ++m) {
                const int row = u.pm * 256 + ai * 128 + wr * 64 + m * 16 + fr;
                const float qs = tab[u.aux * 256 + ai * 128 + wr * 64 + m * 16 + fr] * QS_B;
                if (pn < 2) {
#pragma unroll
                    for (int bj = 0; bj < 2; ++bj) { const int v0 = pn * 256 + bj * 128 + wc * 32 + 8 * fq; const int head = v0 >> 6, d = v0 & 63;
                        *(u32x4*)(QB + (size_t)row * 768 + head * 96 + d) = pack8(acc[ai][bj][m][0] * qs, acc[ai][bj][m][1] * qs); }
                } else {
                    const bool lat = row < SEQ; const float p = (fq & 1) ? (float)(row & 63) : (float)(row >> 6);
                    f32x4 o1[2], o2[2];
#pragma unroll
                    for (int n = 0; n < 2; ++n)
#pragma unroll
                        for (int j = 0; j < 4; ++j) { constexpr float IB[8] = INVB_LIST; float c = 1.f, s = 0.f; if (lat) rope_cs(p, IB[4 * n + j], c, s);
                            const float x1 = acc[ai][0][m][n][j], x2 = acc[ai][1][m][n][j]; o1[n][j] = (x1 * c - x2 * s) * qs; o2[n][j] = (x2 * c + x1 * s) * qs; }
                    const int head = 2 * wc + (fq >> 1); bf16_t* dst = QB + (size_t)row * 768 + head * 96 + 64 + 8 * (fq & 1);
                    *(u32x4*)dst = pack8(o1[0], o1[1]); *(u32x4*)(dst + 16) = pack8(o2[0], o2[1]);
                }
                asm volatile("" ::: "memory");
            }
    }
};
struct EpiUpKV {
    unsigned char* pb; const LAS float* tab;
    __device__ __forceinline__ void operator()(const f32x4 (&acc)[2][2][4][2], const Unit& u, int wr, int wc, int fr, int fq) const {
        const int pn = u.pn; bf16_t* KB = (bf16_t*)(pb + B_KB); bf16_t* VBT = (bf16_t*)(pb + B_VBT);
#pragma unroll
        for (int ai = 0; ai < 2; ++ai)
#pragma unroll
            for (int m = 0; m < 4; ++m) {
                const int row = u.pm * 256 + ai * 128 + wr * 64 + m * 16 + fr;
                const float rs = tab[u.aux * 256 + ai * 128 + wr * 64 + m * 16 + fr];
#pragma unroll
                for (int bj = 0; bj < 2; ++bj) {
                    const int v0 = (pn & 1) * 256 + bj * 128 + wc * 32 + 8 * fq; const int head = v0 >> 6, d = v0 & 63;
                    if (pn < 2) *(u32x4*)(KB + (size_t)row * 768 + head * 96 + d) = pack8(acc[ai][bj][m][0] * rs, acc[ai][bj][m][1] * rs);
                    else {
#pragma unroll
                        for (int n = 0; n < 2; ++n)
#pragma unroll
                            for (int j = 0; j < 4; ++j) VBT[(size_t)(head * 64 + d + 4 * n + j) * RB + row] = (bf16_t)(pk2(acc[ai][bj][m][n][j] * rs, 0.f) & 0xffffu);
                    }
                }
                asm volatile("" ::: "memory");
            }
    }
};
struct EpiMerge {
    unsigned char* pb; int nbj;
    __device__ __forceinline__ void mid(f32x4 (&acc)[2][2][4][2], const Unit& u, int wr, int wc, int fr, int fq) const {
        const int j = u.aux; const bf16_t* G = (const bf16_t*)(pb + B_G);
#pragma unroll
        for (int ai = 0; ai < 2; ++ai) {
            u32x4 g0[4][2], g1[4][2];
#pragma unroll
            for (int m = 0; m < 4; ++m) { const int row = u.pm * 256 + ai * 128 + wr * 64 + m * 16 + fr;
#pragma unroll
                for (int bj = 0; bj < 2; ++bj) { if (bj >= nbj) break;
                    const bf16_t* gp = G + (size_t)row * 3072 + j * 1024 + u.pn * 128 * nbj + bj * 128 + wc * 32 + 8 * fq;
                    g0[m][bj] = *(const u32x4*)gp; g1[m][bj] = *(const u32x4*)(gp + 1024); } }
#pragma unroll
            for (int m = 0; m < 4; ++m)
#pragma unroll
                for (int bj = 0; bj < 2; ++bj) { if (bj >= nbj) break;
                    const u32x4 x = g0[m][bj], y = g1[m][bj];
#define RT_(a_, b_) ((a_) * __builtin_amdgcn_rcpf(fmaxf((b_), 1e-30f)))
                    acc[ai][bj][m][0][0] *= RT_(bflo(x.x), bflo(y.x)); acc[ai][bj][m][0][1] *= RT_(bfhi(x.x), bfhi(y.x)); acc[ai][bj][m][0][2] *= RT_(bflo(x.y), bflo(y.y)); acc[ai][bj][m][0][3] *= RT_(bfhi(x.y), bfhi(y.y));
                    acc[ai][bj][m][1][0] *= RT_(bflo(x.z), bflo(y.z)); acc[ai][bj][m][1][1] *= RT_(bfhi(x.z), bfhi(y.z)); acc[ai][bj][m][1][2] *= RT_(bflo(x.w), bflo(y.w)); acc[ai][bj][m][1][3] *= RT_(bfhi(x.w), bfhi(y.w));
#undef RT_
                }
            asm volatile("" ::: "memory");
        }
    }
    __device__ __forceinline__ void operator()(const f32x4 (&acc)[2][2][4][2], const Unit& u, int wr, int wc, int fr, int fq) const {
        const int j = u.aux; const bf16_t* G = (const bf16_t*)(pb + B_G); bf16_t* M = (bf16_t*)(pb + B_M);
#pragma unroll
        for (int ai = 0; ai < 2; ++ai) {
            u32x4 g[4][2];
#pragma unroll
            for (int m = 0; m < 4; ++m) { const int row = u.pm * 256 + ai * 128 + wr * 64 + m * 16 + fr;
#pragma unroll
                for (int bj = 0; bj < 2; ++bj) { if (bj >= nbj) break;
                    g[m][bj] = *(const u32x4*)(G + (size_t)row * 3072 + j * 1024 + u.pn * 128 * nbj + bj * 128 + wc * 32 + 8 * fq); } }
#pragma unroll
            for (int m = 0; m < 4; ++m) { const int row = u.pm * 256 + ai * 128 + wr * 64 + m * 16 + fr;
#pragma unroll
                for (int bj = 0; bj < 2; ++bj) { if (bj >= nbj) break;
                    const int col = u.pn * 128 * nbj + bj * 128 + wc * 32 + 8 * fq;
                    const u32x4 gg = g[m][bj];
                    f32x4 a = acc[ai][bj][m][0], b2 = acc[ai][bj][m][1];
                    a[0] *= bflo(gg.x); a[1] *= bfhi(gg.x); a[2] *= bflo(gg.y); a[3] *= bfhi(gg.y); b2[0] *= bflo(gg.z); b2[1] *= bfhi(gg.z); b2[2] *= bflo(gg.w); b2[3] *= bfhi(gg.w);
                    *(u32x4*)(M + (size_t)row * 1024 + col) = pack8(a, b2); } }
            asm volatile("" ::: "memory");
        }
    }
};
struct EpiOut {
    bf16_t* O; int nbj;
    __device__ __forceinline__ void operator()(const f32x4 (&acc)[2][2][4][2], const Unit& u, int wr, int wc, int fr, int fq) const {
#pragma unroll
        for (int ai = 0; ai < 2; ++ai)
#pragma unroll
            for (int m = 0; m < 4; ++m) {
                const int row = u.pm * 256 + ai * 128 + wr * 64 + m * 16 + fr;
#pragma unroll
                for (int bj = 0; bj < 2; ++bj) { if (bj >= nbj) break;
                    *(u32x4*)(O + (size_t)row * 1024 + u.pn * 128 * nbj + bj * 128 + wc * 32 + 8 * fq) = pack8(acc[ai][bj][m][0], acc[ai][bj][m][1]); }
            }
    }
};

template <int DQK, bool WIN>
__device__ __forceinline__ void attn_unit(LAS unsigned char* lds, const bf16_t* __restrict__ Q, const int qpitch, const bf16_t* __restrict__ Kp, const int kpitch,
                                          const bf16_t* __restrict__ VT, bf16_t* Y, const int q0, const int a0, const int n1, const int b0, const int n2,
                                          const float m_init, const float l_init, const int wave_s, const bool do_store = true) {
    constexpr int CPR = DQK / 8, KROW = DQK * 2, KSLOT = 64 * KROW, VSLOT = 8192, NS = 4, KI = KSLOT / 1024, ND = DQK / 16, VBASE = NS * KSLOT;
    const int tid = tid_from_wave(wave_s);
    const int lane = tid & 63, wid = wave_s, r32 = lane & 31, hi = lane >> 5;
    const int NT = n1 + n2;
    int ksrc[2];
#pragma unroll
    for (int i = 0; i < 2; ++i) { const int cc = 64 * (wid + 8 * i) + lane; const int rho = cc / CPR, pos = cc % CPR;
        const int ch = (DQK == 96) ? ((pos & ~3) | ((pos & 3) ^ ((rho >> 2) & 3))) : (pos ^ ((rho >> 1) & 7));
        const int key = (rho & ~12) | ((rho & 4) << 1) | ((rho & 8) >> 1);
        ksrc[i] = key * kpitch + ch * 8; }
    int vsrc; { const int cc = 64 * wid + lane; const int d = cc >> 3, pos = cc & 7; vsrc = d * RB + ((pos ^ ((d >> 1) & 7)) * 8); }
    const bool k2 = (wid + 8 < KI);
    int kofs[ND], vofs[4];
#pragma unroll
    for (int d0 = 0; d0 < ND; ++d0) { const int c = 2 * d0 + hi; const int pos = (DQK == 96) ? ((c & ~3) | ((c & 3) ^ ((r32 >> 2) & 3))) : (c ^ ((r32 >> 1) & 7)); kofs[d0] = r32 * KROW + pos * 16; }
#pragma unroll
    for (int sl = 0; sl < 4; ++sl) vofs[sl] = r32 * 128 + (((2 * sl + hi) ^ ((r32 >> 1) & 7)) * 16);
    const int qrow = q0 + wid * 32 + r32;
    bf16x8 qf[ND];
    { const bf16_t* qp = Q + (size_t)qrow * qpitch + hi * 8;
#pragma unroll
      for (int d0 = 0; d0 < ND; ++d0) qf[d0] = *(const bf16x8*)(qp + d0 * 16); }
    f32x16 o0, o1;
#pragma unroll
    for (int r = 0; r < 16; ++r) { o0[r] = 0.f; o1[r] = 0.f; }
    float mrun = m_init, lrun = (hi == 0) ? l_init : 0.f;
#define TROW(t) ((t) < n1 ? a0 + 64 * (t) : b0 + 64 * ((t) - n1))
#define DMA_K(t, slot) do { const int tt_ = ((t) < NT) ? (t) : NT - 1; const bf16_t* kb_ = Kp + (size_t)TROW(tt_) * kpitch; \
        __builtin_amdgcn_global_load_lds((const unsigned*)(kb_ + ksrc[0]), (LAS unsigned*)(lds + (slot) * KSLOT + wid * 1024), 16, 0, 0); \
        if (k2) __builtin_amdgcn_global_load_lds((const unsigned*)(kb_ + ksrc[1]), (LAS unsigned*)(lds + (slot) * KSLOT + (wid + 8) * 1024), 16, 0, 0); } while (0)
#define DMA_V(t, slot) do { const int tt_ = ((t) < NT) ? (t) : NT - 1; \
        __builtin_amdgcn_global_load_lds((const unsigned*)(VT + TROW(tt_) + vsrc), (LAS unsigned*)(lds + VBASE + (slot) * VSLOT + wid * 1024), 16, 0, 0); } while (0)
#define QKT(S0, S1, slot) do { const LAS unsigned char* Kb_ = lds + (slot) * KSLOT; \
        _Pragma("unroll") for (int d0 = 0; d0 < ND; ++d0) { \
            const bf16x8 k0_ = *(const LAS bf16x8*)(Kb_ + kofs[d0]); const bf16x8 k1_ = *(const LAS bf16x8*)(Kb_ + 32 * KROW + kofs[d0]); \
            S0 = __builtin_amdgcn_mfma_f32_32x32x16_bf16(k0_, qf[d0], S0, 0, 0, 0); S1 = __builtin_amdgcn_mfma_f32_32x32x16_bf16(k1_, qf[d0], S1, 0, 0, 0); } } while (0)
    DMA_K(0, 0); DMA_K(1, 1); DMA_V(0, 0); DMA_K(2, 2); DMA_V(1, 1);
    asm volatile("s_waitcnt vmcnt(0) lgkmcnt(0)\n\ts_barrier" ::: "memory");
    f32x16 s0, s1;
#pragma unroll
    for (int r = 0; r < 16; ++r) { s0[r] = 0.f; s1[r] = 0.f; }
    QKT(s0, s1, 0);
    const f32x16 zero16 = {0.f, 0.f, 0.f, 0.f, 0.f, 0.f, 0.f, 0.f, 0.f, 0.f, 0.f, 0.f, 0.f, 0.f, 0.f, 0.f};
#define MASKT(S0, S1, T) do { if (WIN) { const int kt_ = TROW(T); \
          if (kt_ < SEQ) { const int base_ = kt_ + 8 * hi - qrow; \
              _Pragma("unroll") for (int r = 0; r < 16; ++r) { const int dd_ = base_ + 16 * (r >> 3) + (r & 7); \
                  if (dd_ > 128 || dd_ < -128) S0[r] = NEG; if (dd_ + 32 > 128 || dd_ + 32 < -128) S1[r] = NEG; } } } } while (0)
#define ROWMAX(MX, S0, S1) do { MX = fmaxf(fmaxf(S0[0], S1[0]), S0[1]); \
      _Pragma("unroll") for (int r = 1; r < 16; ++r) { MX = fmaxf(fmaxf(MX, S1[r]), (r < 15) ? S0[r + 1] : S1[r]); } \
      { auto rr_ = __builtin_amdgcn_permlane32_swap(__float_as_uint(MX), __float_as_uint(MX), false, false); MX = fmaxf(__uint_as_float(rr_[0]), __uint_as_float(rr_[1])); } } while (0)
    float mxn;
    { MASKT(s0, s1, 0);
      float mx; ROWMAX(mx, s0, s1);
      const float m0 = fmaxf(m_init, mx);
      lrun *= fexp2(m_init - m0); mrun = m0; mxn = m0; }
    bool resc = false;
#define LOADKF(T1) do { const LAS unsigned char* Kb_ = lds + ((T1) & 3) * KSLOT; \
          _Pragma("unroll") for (int d0 = 0; d0 < ND; ++d0) { kf0[d0] = *(const LAS bf16x8*)(Kb_ + kofs[d0]); kf1[d0] = *(const LAS bf16x8*)(Kb_ + 32 * KROW + kofs[d0]); } } while (0)
    bf16x8 kf0[ND], kf1[ND];
    LOADKF(1);
#define STEP(S0, S1, N0, N1, T) do { \
        DMA_K((T) + 3, ((T) + 3) & 3); DMA_V((T) + 2, ((T) + 2) & 3); \
        if (resc) {                                 \
            const float dl = fmaxf(mxn - mrun, 0.f); mrun += dl; const float alpha = fexp2(-dl); lrun *= alpha; \
            _Pragma("unroll") for (int r = 0; r < 16; ++r) { o0[r] *= alpha; o1[r] *= alpha; } } \
        N0 = __builtin_amdgcn_mfma_f32_32x32x16_bf16(kf0[0], qf[0], zero16, 0, 0, 0); N1 = __builtin_amdgcn_mfma_f32_32x32x16_bf16(kf1[0], qf[0], zero16, 0, 0, 0); \
        _Pragma("unroll") for (int d0 = 1; d0 < ND; ++d0) { N0 = __builtin_amdgcn_mfma_f32_32x32x16_bf16(kf0[d0], qf[d0], N0, 0, 0, 0); N1 = __builtin_amdgcn_mfma_f32_32x32x16_bf16(kf1[d0], qf[d0], N1, 0, 0, 0); } \
        asm volatile("" ::: "memory");              \
        bf16x8 vfa[4], vfc[4]; \
        { const LAS unsigned char* Vb_ = lds + VBASE + ((T) & 3) * VSLOT; \
          _Pragma("unroll") for (int sl = 0; sl < 4; ++sl) { vfa[sl] = *(const LAS bf16x8*)(Vb_ + vofs[sl]); vfc[sl] = *(const LAS bf16x8*)(Vb_ + 4096 + vofs[sl]); } } \
        float ps = 0.f; \
        _Pragma("unroll") for (int r = 0; r < 16; ++r) { S0[r] = fexp2(S0[r] - mrun); S1[r] = fexp2(S1[r] - mrun); ps += S0[r] + S1[r]; } \
        lrun += ps; \
        u32x4 pb[4]; \
        _Pragma("unroll") for (int h2 = 0; h2 < 2; ++h2) { \
            pb[h2] = (u32x4){pk2(S0[8 * h2], S0[8 * h2 + 1]), pk2(S0[8 * h2 + 2], S0[8 * h2 + 3]), pk2(S0[8 * h2 + 4], S0[8 * h2 + 5]), pk2(S0[8 * h2 + 6], S0[8 * h2 + 7])}; \
            pb[2 + h2] = (u32x4){pk2(S1[8 * h2], S1[8 * h2 + 1]), pk2(S1[8 * h2 + 2], S1[8 * h2 + 3]), pk2(S1[8 * h2 + 4], S1[8 * h2 + 5]), pk2(S1[8 * h2 + 6], S1[8 * h2 + 7])}; } \
          \
          \
        if (k2) asm volatile("s_waitcnt vmcnt(3) lgkmcnt(0)\n\ts_barrier" : "+v"(pb[0]), "+v"(pb[1]), "+v"(pb[2]), "+v"(pb[3]), "+v"(lrun) :: "memory"); \
        else asm volatile("s_waitcnt vmcnt(2) lgkmcnt(0)\n\ts_barrier" : "+v"(pb[0]), "+v"(pb[1]), "+v"(pb[2]), "+v"(pb[3]), "+v"(lrun) :: "memory"); \
        LOADKF((T) + 2); \
        _Pragma("unroll") for (int sl = 0; sl < 4; ++sl) { \
            o0 = __builtin_amdgcn_mfma_f32_32x32x16_bf16(vfa[sl], __builtin_bit_cast(bf16x8, pb[sl]), o0, 0, 0, 0); \
            o1 = __builtin_amdgcn_mfma_f32_32x32x16_bf16(vfc[sl], __builtin_bit_cast(bf16x8, pb[sl]), o1, 0, 0, 0); } \
        MASKT(N0, N1, (T) + 1); \
        ROWMAX(mxn, N0, N1); \
        resc = __any(mxn - mrun > 8.0f); \
    } while (0)
    f32x16 u0, u1;
    if (wid >= 4) __builtin_amdgcn_s_setprio(1);
    for (int t = 0; t < NT; t += 2) {
        STEP(s0, s1, u0, u1, t);
        STEP(u0, u1, s0, s1, t + 1);
    }
#undef STEP
#undef LOADKF
#undef MASKT
#undef ROWMAX
    __builtin_amdgcn_s_setprio(0);
    asm volatile("s_waitcnt vmcnt(0) lgkmcnt(0)\n\ts_barrier" ::: "memory");
#undef TROW
#undef DMA_K
#undef DMA_V
#undef QKT
    lrun += shx(lrun, 32, lane);
    const float inv = 1.0f / lrun;
    bf16_t* yrow = Y + (size_t)qrow * 512;
#pragma unroll
    for (int db = 0; db < 2; ++db)
#pragma unroll
        for (int g = 0; g < 4; ++g) {
            const int d0 = 32 * db + 8 * g + 4 * hi; u32x2* yp = (u32x2*)(yrow + d0); const u32x2 z = *yp;
            const f32x16& o = db ? o1 : o0; u32x2 w;
            w.x = pk2(o[4 * g] * inv * bflo(z.x), o[4 * g + 1] * inv * bfhi(z.x)); w.y = pk2(o[4 * g + 2] * inv * bflo(z.y), o[4 * g + 3] * inv * bfhi(z.y));
            if (do_store) *yp = w;
        }
}

#define XB_TMO      128
#define XB_XCNT(j)  (256  + 64 * (j))
#define XB_XSUB(j)  (1280 + 64 * (j))
#define XB_XGEN(j)  (2304 + 64 * (j))
#define XB_TOP      3328
#define XB_TOPGEN   3392
#define XCD_BAR_WORDS 3456
#define XB_SPIN_CAP (1u << 18)

__device__ __forceinline__ unsigned xb_ld(unsigned* p)              { return __hip_atomic_load(p, __ATOMIC_RELAXED, __HIP_MEMORY_SCOPE_AGENT); }
__device__ __forceinline__ unsigned xb_add(unsigned* p, unsigned v) { return __hip_atomic_fetch_add(p, v, __ATOMIC_RELAXED, __HIP_MEMORY_SCOPE_AGENT); }
__device__ __forceinline__ unsigned xb_xcc_id() { return (unsigned)__builtin_amdgcn_s_getreg((3 << 11) | 20) & 0xFu; }
#define XB_SPIN(cond, bar) do { unsigned _sp = 0; while (cond) { __builtin_amdgcn_s_sleep(1); \
    if ((++_sp & 255u) == 0u) { if (xb_ld(&(bar)[XB_TMO])) break; if (_sp > XB_SPIN_CAP) { atomicAdd(&(bar)[XB_TMO], 1u); break; } } } } while (0)

struct XcdBarrier {
    unsigned* bar; unsigned x;
    volatile LAS unsigned* st;
};

__device__ __forceinline__ XcdBarrier xcd_barrier_post(unsigned* bar, volatile LAS unsigned* st, const int wave_s) {
    XcdBarrier b; b.bar = bar; b.x = xb_xcc_id(); b.st = st;
    if (tid_from_wave(wave_s) == 0) (void)xb_add(&bar[XB_XCNT(b.x)], 1u);
    return b;
}
__device__ __forceinline__ void xcd_barrier_complete(unsigned* bar, unsigned x, unsigned& nloc, unsigned& nx) {
    const unsigned G = gridDim.x * gridDim.y * gridDim.z;
    unsigned sum, cnt, mine, sp = 0u;
    for (;;) {
        sum = 0u; cnt = 0u; mine = 0u;
#pragma unroll
        for (unsigned j = 0; j < 16; ++j) { const unsigned c = xb_ld(&bar[XB_XCNT(j)]); sum += c; cnt += (c > 0u) ? 1u : 0u; mine = (j == x) ? c : mine; }
        if (sum == G) break;
        __builtin_amdgcn_s_sleep(1);
        if ((++sp & 255u) == 0u) { if (xb_ld(&bar[XB_TMO])) break; if (sp > XB_SPIN_CAP) { atomicAdd(&bar[XB_TMO], 1u); break; } }
    }
    nloc = mine > 0u ? mine : 1u; nx = cnt > 0u ? cnt : 1u;
}

__device__ __forceinline__ void xcd_barrier(const XcdBarrier& b, const int wave_s) {
    asm volatile("s_waitcnt vmcnt(0)" ::: "memory");
    __syncthreads();
    if (tid_from_wave(wave_s) == 0) {
        unsigned* bar = b.bar;
        __builtin_amdgcn_s_waitcnt(0);
        unsigned nloc = b.st[0], nx = b.st[1];
        if (nloc == 0u) { xcd_barrier_complete(bar, b.x, nloc, nx); b.st[0] = nloc; b.st[1] = nx; }
        const unsigned old = xb_add(&bar[XB_XSUB(b.x)], 1u);
        const unsigned gen = old / nloc;
        if (old + 1u == (gen + 1u) * nloc) {
            __builtin_amdgcn_fence(__ATOMIC_RELEASE, "agent");
            asm volatile("s_waitcnt vmcnt(0)" ::: "memory");
            const unsigned og = xb_add(&bar[XB_TOP], 1u);
            const unsigned tg = og / nx;
            if (og + 1u == (tg + 1u) * nx) xb_add(&bar[XB_TOPGEN], 1u);
            else XB_SPIN(xb_ld(&bar[XB_TOPGEN]) == tg, bar);
            __builtin_amdgcn_fence(__ATOMIC_ACQUIRE, "agent");
            xb_add(&bar[XB_XGEN(b.x)], 1u);
            asm volatile("s_waitcnt vmcnt(0)" ::: "memory");
        } else {
            XB_SPIN(xb_ld(&bar[XB_XGEN(b.x)]) == gen, bar);
            __builtin_amdgcn_fence(__ATOMIC_ACQUIRE, "agent");
            asm volatile("s_waitcnt vmcnt(0)" ::: "memory");
        }
    }
    __syncthreads();
}


__device__ __forceinline__ int map_in(int v) {
    const int pn = v >> 8, bj = (v >> 7) & 1, u = v & 127;
    if (pn < 2) return (4 * pn + (u >> 5)) * 64 + (u & 31) + 32 * bj;
    if (pn == 2) return (u < 64) ? 512 + (u >> 5) * 64 + (u & 31) + 32 * bj : 640 + bj * 64 + (u - 64);
    if (pn <= 4) return v;
    if (pn <= 7) { const int lv = v - 1280; return lv < 384 ? 1280 + lv : (lv < 640 ? 1664 + (lv - 384) : (lv < 672 ? 1920 + (lv - 640) : -1)); }
    if (pn <= 9) return 1952 + (v - 2048);
    if (pn <= 17) { const int wc = u >> 5, fq = (u >> 3) & 3, n = (u >> 2) & 1, j = u & 3; const int ch = (pn - 10) * 64 + wc * 16 + fq * 4 + j; return 2464 + (2 * bj + n) * 512 + ch; }
    return 4512 + (v - 4608);
}
__device__ __forceinline__ int map_qb(int v) { if (v < 512) return (v >> 6) * 96 + (v & 63); const int bj = (v >> 7) & 1, u = v & 127; return (u >> 4) * 96 + 64 + (u & 15) + 16 * bj; }
__device__ __forceinline__ int map_kvb(int v) { if (v < 512) return (v >> 6) * 128 + (v & 63); const int w = v - 512; return (w >> 6) * 128 + 64 + (w & 63); }

template <int MAP> __device__ __forceinline__ void transpose_item(const float* __restrict__ W, int K, int N, bf16_t* WT, const float* gk, LAS float* scr, int item, int nblk, int lane) {
    const int kb = item / nblk, nb = item % nblk, k0 = 64 * kb, v0 = 32 * nb;
    const int kr = lane >> 3, nq = lane & 7; const int v = v0 + 4 * nq;
    const int col = MAP == 0 ? v : (MAP == 1 ? map_in(v) : (MAP == 2 ? map_qb(v) : map_kvb(v)));
    f32x4 x[8];
#pragma unroll
    for (int i = 0; i < 8; ++i) x[i] = (col >= 0) ? *(const f32x4*)(W + (size_t)(k0 + 8 * i + kr) * N + col) : (f32x4){0.f, 0.f, 0.f, 0.f};
#pragma unroll
    for (int i = 0; i < 8; ++i) { const int kk = 8 * i + kr; const float g = gk ? gk[k0 + kk] : 1.0f; LAS float* d = scr + kk * 33 + 4 * nq; d[0] = x[i][0] * g; d[1] = x[i][1] * g; d[2] = x[i][2] * g; d[3] = x[i][3] * g; }
    asm volatile("s_waitcnt lgkmcnt(0)" ::: "memory");
    const int c = lane & 7;
#pragma unroll
    for (int j = 0; j < 4; ++j) { const int n = (lane >> 3) + 8 * j; const LAS float* s = scr + (8 * c) * 33 + n;
        u32x4 o; o.x = pk2(s[0 * 33], s[1 * 33]); o.y = pk2(s[2 * 33], s[3 * 33]); o.z = pk2(s[4 * 33], s[5 * 33]); o.w = pk2(s[6 * 33], s[7 * 33]);
        *(u32x4*)(WT + (size_t)(v0 + n) * K + k0 + 8 * c) = o; }
    asm volatile("s_waitcnt lgkmcnt(0)" ::: "memory");
}

typedef const __attribute__((address_space(1))) float* gcf_t;
constexpr int I_IN = 16 * (NV / 32), I_QB = 6 * 24, I_KVB = 4 * 32, I_BR1 = 8 * 32, I_O = 16 * 32, I_L = I_IN + I_QB + I_KVB + 3 * I_BR1 + I_O;
struct Args {
    gcf_t x, c, ctx, c_ctx, w_mod, b_mod, g_pre, g_post, w_in, sink, g_qa, w_qb, g_kva, w_kvb, conv_w, w_branch, w_o;
    __attribute__((address_space(1))) float* out; __attribute__((address_space(1))) unsigned char* ws;
};

__device__ __forceinline__ void hx_row(const float* xrow, const float* g, const float* mod  , bf16_t* orow, int lane) {
    f32x4 v[4]; float s = 0.f;
#pragma unroll
    for (int j = 0; j < 4; ++j) { v[j] = *(const f32x4*)(xrow + 4 * lane + 256 * j); s += (v[j][0] * v[j][0] + v[j][1] * v[j][1]) + (v[j][2] * v[j][2] + v[j][3] * v[j][3]); }
    const float rstd = __builtin_amdgcn_rsqf(wave_sum(s, lane) * (1.0f / DM) + EPS);
#pragma unroll
    for (int j = 0; j < 4; ++j) { const int c = 4 * lane + 256 * j; const f32x4 gg = *(const f32x4*)(g + c), sh = *(const f32x4*)(mod + c), sc = *(const f32x4*)(mod + 1024 + c);
        f32x4 h;
#pragma unroll
        for (int e = 0; e < 4; ++e) h[e] = v[j][e] * rstd * gg[e] * (1.0f + sc[e]) + sh[e];
        u32x2 w; w.x = pk2(h[0], h[1]); w.y = pk2(h[2], h[3]); *(u32x2*)(orow + c) = w; }
}


__device__ __forceinline__ void p6_pass(const float* xbase, float* dstbase, const bf16_t* obase, bf16_t* hbase, const float* gp, const float* mod, const float* g1, const float* mod1,
                                        const int nrows, const int gw, const int NGW, const int lane) {
    if (gw >= nrows) return;
    f32x4 gpv[4], gtv[4], g1v[4], shv[4], scv[4];
#pragma unroll
    for (int j = 0; j < 4; ++j) { const int c = 4 * lane + 256 * j; gpv[j] = *(const f32x4*)(gp + c); gtv[j] = *(const f32x4*)(mod + 2048 + c);
        if (hbase) { g1v[j] = *(const f32x4*)(g1 + c); shv[j] = *(const f32x4*)(mod1 + c); scv[j] = *(const f32x4*)(mod1 + 1024 + c); } }
    int r = gw; u32x2 ow[4]; f32x4 xv[4];
#pragma unroll
    for (int j = 0; j < 4; ++j) { ow[j] = *(const u32x2*)(obase + (size_t)r * DM + 4 * lane + 256 * j); xv[j] = *(const f32x4*)(xbase + (size_t)r * DM + 4 * lane + 256 * j); }
    for (;;) {
        const int rn = r + NGW; const bool hn = rn < nrows; const int rl = hn ? rn : r;
        u32x2 now_[4]; f32x4 nxv[4];
#pragma unroll
        for (int j = 0; j < 4; ++j) { now_[j] = *(const u32x2*)(obase + (size_t)rl * DM + 4 * lane + 256 * j); nxv[j] = *(const f32x4*)(xbase + (size_t)rl * DM + 4 * lane + 256 * j); }
        float ov[4][4]; float s = 0.f;
#pragma unroll
        for (int j = 0; j < 4; ++j) { ov[j][0] = bflo(ow[j].x); ov[j][1] = bfhi(ow[j].x); ov[j][2] = bflo(ow[j].y); ov[j][3] = bfhi(ow[j].y);
            s += (ov[j][0] * ov[j][0] + ov[j][1] * ov[j][1]) + (ov[j][2] * ov[j][2] + ov[j][3] * ov[j][3]); }
        const float rstd = __builtin_amdgcn_rsqf(wave_sum(s, lane) * (1.0f / DM) + EPS);
        f32x4 x1[4]; float s1 = 0.f;
#pragma unroll
        for (int j = 0; j < 4; ++j) { const int c = 4 * lane + 256 * j;
#pragma unroll
            for (int e = 0; e < 4; ++e) { x1[j][e] = xv[j][e] + gtv[j][e] * (ov[j][e] * rstd * gpv[j][e]); s1 += x1[j][e] * x1[j][e]; }
            *(f32x4*)(dstbase + (size_t)r * DM + c) = x1[j]; }
        if (hbase) {
            const float rstd1 = __builtin_amdgcn_rsqf(wave_sum(s1, lane) * (1.0f / DM) + EPS);
#pragma unroll
            for (int j = 0; j < 4; ++j) { const int c = 4 * lane + 256 * j; f32x4 h;
#pragma unroll
                for (int e = 0; e < 4; ++e) h[e] = x1[j][e] * rstd1 * g1v[j][e] * (1.0f + scv[j][e]) + shv[j][e];
                u32x2 w; w.x = pk2(h[0], h[1]); w.y = pk2(h[2], h[3]); *(u32x2*)(hbase + (size_t)r * DM + c) = w; }
        }
        if (!hn) break;
#pragma unroll
        for (int j = 0; j < 4; ++j) { ow[j] = now_[j]; xv[j] = nxv[j]; }
        r = rn;
    }
}
__device__ __forceinline__ void hx_pass(const float* xbase, bf16_t* hbase, const float* g, const float* mod, const int nrows, const int gw, const int NGW, const int lane) {
    if (gw >= nrows) return;
    f32x4 gv[4], shv[4], scv[4];
#pragma unroll
    for (int j = 0; j < 4; ++j) { const int c = 4 * lane + 256 * j; gv[j] = *(const f32x4*)(g + c); shv[j] = *(const f32x4*)(mod + c); scv[j] = *(const f32x4*)(mod + 1024 + c); }
    int r = gw; f32x4 xv[4];
#pragma unroll
    for (int j = 0; j < 4; ++j) xv[j] = *(const f32x4*)(xbase + (size_t)r * DM + 4 * lane + 256 * j);
    for (;;) {
        const int rn = r + NGW; const bool hn = rn < nrows; const int rl = hn ? rn : r;
        f32x4 nxv[4];
#pragma unroll
        for (int j = 0; j < 4; ++j) nxv[j] = *(const f32x4*)(xbase + (size_t)rl * DM + 4 * lane + 256 * j);
        float s = 0.f;
#pragma unroll
        for (int j = 0; j < 4; ++j) s += (xv[j][0] * xv[j][0] + xv[j][1] * xv[j][1]) + (xv[j][2] * xv[j][2] + xv[j][3] * xv[j][3]);
        const float rstd = __builtin_amdgcn_rsqf(wave_sum(s, lane) * (1.0f / DM) + EPS);
#pragma unroll
        for (int j = 0; j < 4; ++j) { const int c = 4 * lane + 256 * j; f32x4 h;
#pragma unroll
            for (int e = 0; e < 4; ++e) h[e] = xv[j][e] * rstd * gv[j][e] * (1.0f + scv[j][e]) + shv[j][e];
            u32x2 w; w.x = pk2(h[0], h[1]); w.y = pk2(h[2], h[3]); *(u32x2*)(hbase + (size_t)r * DM + c) = w; }
        if (!hn) break;
#pragma unroll
        for (int j = 0; j < 4; ++j) xv[j] = nxv[j];
        r = rn;
    }
}


struct ResidHook {
    unsigned char* ws; int L_, B_, bid, G, wave_s; bool on;
    __device__ __forceinline__ void operator()() const {
        if (!on) return;
        const __attribute__((address_space(4))) Args& a_ = *(const __attribute__((address_space(4))) Args*)__builtin_amdgcn_kernarg_segment_ptr();
        float* MOD = (float*)(ws + WS_MOD); float* CTX1 = (float*)(ws + WS_CTX1); bf16_t* HX = (bf16_t*)(ws + WS_HX); bf16_t* OUTB = (bf16_t*)(ws + WS_PB + B_OUT);
        const bool upd_ = (L_ < DEPTH - 1); const int lane_ = tid_from_wave(wave_s) & 63, gw_ = bid * 8 + wave_s, NGW = G * 8;
        const float* gp_ = (const float*)(a_.g_post + (size_t)L_ * DM); const float* g1_ = upd_ ? (const float*)(a_.g_pre + (size_t)(L_ + 1) * DM) : gp_;
        const float* xlat_ = (L_ == 0 ? (const float*)a_.x : (const float*)a_.out) + (size_t)B_ * SEQ * DM;
        const int ex_ = (33 * (NV / 256)) % G; const int light_ = (ex_ > 0 && G == 256) ? G - ex_ : 0; const int nA_ = SEQ - (light_ > 0 ? (SEQ * 11 / 100) / 4 * 4 : 0);
        p6_pass(xlat_, (float*)a_.out + (size_t)B_ * SEQ * DM, OUTB, upd_ ? HX + (size_t)B_ * RB * DM : nullptr, gp_, MOD + ((size_t)L_ * 3 + B_) * 3072, g1_,
                MOD + ((size_t)(upd_ ? L_ + 1 : L_) * 3 + B_) * 3072, nA_, gw_, NGW, lane_);
        if (light_ > 0 && bid >= G - light_)
            p6_pass(xlat_ + (size_t)nA_ * DM, (float*)a_.out + ((size_t)B_ * SEQ + nA_) * DM, OUTB + (size_t)nA_ * DM, upd_ ? HX + ((size_t)B_ * RB + nA_) * DM : nullptr, gp_, MOD + ((size_t)L_ * 3 + B_) * 3072, g1_,
                    MOD + ((size_t)(upd_ ? L_ + 1 : L_) * 3 + B_) * 3072, SEQ - nA_, (bid - (G - light_)) * 8 + wave_s, light_ * 8, lane_);
        if (upd_) { const float* xc_ = (L_ == 0 ? (const float*)a_.ctx : (const float*)CTX1) + (size_t)B_ * CTX * DM;
            p6_pass(xc_, CTX1 + (size_t)B_ * CTX * DM, OUTB + (size_t)SEQ * DM, HX + ((size_t)B_ * RB + SEQ) * DM, gp_, MOD + ((size_t)L_ * 3 + 2) * 3072, g1_, MOD + ((size_t)(L_ + 1) * 3 + 2) * 3072,
                    CTX, gw_, NGW, lane_); }
    }
};

__global__ void __launch_bounds__(512, 2) fwd_megakernel(Args kargs_unused) {
    extern __shared__ __attribute__((aligned(16))) unsigned char smem[];
    LAS unsigned char* lds = (LAS unsigned char*)smem;
    cg::grid_group grid = cg::this_grid();
#define GSYNC() do { XcdBarrier xb_; xb_.bar = (unsigned*)(OPQ_WS() + WS_BAR); xb_.x = xb_xcc_id(); xb_.st = (volatile LAS unsigned*)(lds + LDS_MISC); xcd_barrier(xb_, wave_s); } while (0)
    const int wave_s = __builtin_amdgcn_readfirstlane(threadIdx.x >> 6);
    const int tid = tid_from_wave(wave_s), lane = tid & 63, wave = wave_s;
    const int G0 = gridDim.x, bid0 = blockIdx.x;
    const int G = G0, bid = bid0;
    const int gw = bid * 8 + wave, NGW = G * 8;
#define KARGS() ({ const __attribute__((address_space(4))) Args* p_ = (const __attribute__((address_space(4))) Args*)__builtin_amdgcn_kernarg_segment_ptr(); asm volatile("" : "+s"(p_)); p_; })
    unsigned char* const ws0 = (unsigned char*)KARGS()->ws;
    if (tid < 64) ((LAS unsigned*)(lds + LDS_MISC))[tid] = 0u;
    __syncthreads();
    if (bid0 == 0) { for (int i = tid; i < (int)(BAR_BYTES / 4); i += 512) ((unsigned*)(ws0 + WS_BAR))[i] = 0u; __threadfence(); }
#define OPQ_WS() ({ __attribute__((address_space(1))) unsigned char* w_ = (__attribute__((address_space(1))) unsigned char*)ws0; asm volatile("" : "+s"(w_)); (unsigned char*)w_; })
#define PHASE_PTRS() int G = G0, bid = bid0; asm volatile("" : "+s"(G), "+s"(bid)); const int NGW = G * 8; (void)NGW; unsigned char* ws = OPQ_WS(); unsigned char* pb = ws + WS_PB; float* MOD = (float*)(ws + WS_MOD); float* CTX1 = (float*)(ws + WS_CTX1); bf16_t* HX = (bf16_t*)(ws + WS_HX); \
    bf16_t *QA = (bf16_t*)(pb + B_QA), *KA = (bf16_t*)(pb + B_KA), *VAT = (bf16_t*)(pb + B_VAT), *QLAT = (bf16_t*)(pb + B_QLAT), *KVLAT = (bf16_t*)(pb + B_KVLAT), \
           *QB = (bf16_t*)(pb + B_QB), *KB = (bf16_t*)(pb + B_KB), *VBT = (bf16_t*)(pb + B_VBT), *YA = (bf16_t*)(pb + B_YA), *YB = (bf16_t*)(pb + B_YB), \
           *PC = (bf16_t*)(pb + B_PC), *ZC = (bf16_t*)(pb + B_ZC), *OUTB = (bf16_t*)(pb + B_OUT), *MB = (bf16_t*)(pb + B_M); \
    (void)MOD; (void)CTX1; (void)HX; (void)QA; (void)KA; (void)VAT; (void)QLAT; (void)KVLAT; (void)QB; (void)KB; (void)VBT; (void)YA; (void)YB; (void)PC; (void)ZC; (void)OUTB; (void)MB;
    if (PH_MASK & 1) {
        PHASE_PTRS();
        const __attribute__((address_space(4))) Args& a = *KARGS();
        LAS float* scr = (LAS float*)(lds + wave * 16384);
#define CONVERT_LAYER(l, w0, nw, i0, i1) do { unsigned char* wl_ = ws + WS_W + (size_t)(l) * W_STRIDE; \
        for (int it = (i0) + (w0); it < (i1); it += (nw)) { int r = it; \
            if (r < I_IN) { transpose_item<1>((const float*)(a.w_in + (size_t)(l) * DM * D_IN), DM, D_IN, (bf16_t*)(wl_ + W_IN), nullptr, scr, r, NV / 32, lane); continue; } r -= I_IN; \
            if (r < I_QB) { transpose_item<2>((const float*)(a.w_qb + (size_t)(l) * QLORA * 768), QLORA, 768, (bf16_t*)(wl_ + W_QB), (const float*)(a.g_qa + (l) * QLORA), scr, r, 24, lane); continue; } r -= I_QB; \
            if (r < I_KVB) { transpose_item<3>((const float*)(a.w_kvb + (size_t)(l) * KVLORA * 1024), KVLORA, 1024, (bf16_t*)(wl_ + W_KVB), (const float*)(a.g_kva + (l) * KVLORA), scr, r, 32, lane); continue; } r -= I_KVB; \
            if (r < 3 * I_BR1) { const int j = r / I_BR1; transpose_item<0>((const float*)(a.w_branch + ((size_t)(l) * 3 + j) * 512 * 1024), 512, 1024, (bf16_t*)(wl_ + W_BR) + (size_t)j * 1024 * 512, nullptr, scr, r % I_BR1, 32, lane); continue; } r -= 3 * I_BR1; \
            transpose_item<0>((const float*)(a.w_o + (size_t)(l) * 1024 * 1024), 1024, 1024, (bf16_t*)(wl_ + W_O), nullptr, scr, r, 32, lane); } } while (0)
        CONVERT_LAYER(0, gw, NGW, 0, I_L);
        __syncthreads();
        LAS float* sv = (LAS float*)lds;
        LAS float* red = (LAS float*)(lds + 12288);
        for (int i = tid; i < 3 * 1024; i += 512) { const int v = i >> 10, k = i & 1023; const float xv = (v < 2) ? a.c[v * 1024 + k] : a.c_ctx[k]; sv[i] = siluf_(xv); }
        __syncthreads();
        for (int it = bid; it < DEPTH * 96; it += G) {
            const int l = it / 96, cq = tid & 7, kg = tid >> 3;
            const float* wp = (const float*)(a.w_mod + (size_t)l * DM * 3072 + (size_t)(kg * 16) * 3072 + (it % 96) * 32 + 4 * cq);
            f32x4 wv[16];
#pragma unroll
            for (int kk = 0; kk < 16; ++kk) wv[kk] = *(const f32x4*)(wp + (size_t)kk * 3072);
            f32x4 a0 = {0.f, 0.f, 0.f, 0.f}, a1 = a0, a2 = a0;
#pragma unroll
            for (int kk = 0; kk < 16; ++kk) { const int k = kg * 16 + kk; a0 += wv[kk] * sv[k]; a1 += wv[kk] * sv[1024 + k]; a2 += wv[kk] * sv[2048 + k]; }
#pragma unroll
            for (int e = 0; e < 4; ++e) { red[(0 * 64 + kg) * 32 + 4 * cq + e] = a0[e]; red[(1 * 64 + kg) * 32 + 4 * cq + e] = a1[e]; red[(2 * 64 + kg) * 32 + 4 * cq + e] = a2[e]; }
            __syncthreads();
            if (tid < 96) { const int v = tid >> 5, cl = tid & 31; float s = 0.f;
#pragma unroll 8
                for (int q = 0; q < 64; ++q) s += red[(v * 64 + q) * 32 + cl];
                const int cc = (it % 96) * 32 + cl; MOD[((size_t)l * 3 + v) * 3072 + cc] = s + a.b_mod[l * 3072 + cc]; }
            __syncthreads();
        }
    }
    grid.sync();
    (void)xcd_barrier_post((unsigned*)(OPQ_WS() + WS_BAR), (volatile LAS unsigned*)(lds + LDS_MISC), wave_s);
    if (PH_MASK & 2) {
        PHASE_PTRS();
        const __attribute__((address_space(4))) Args& a = *KARGS();
        for (int b = 0; b < (G > 132 ? 1 : NBATCH); ++b) {
            hx_pass((const float*)a.x + (size_t)b * SEQ * DM, HX + (size_t)b * RB * DM, (const float*)a.g_pre, MOD + (size_t)b * 3072, SEQ, gw, NGW, lane);
            hx_pass((const float*)a.ctx + (size_t)b * CTX * DM, HX + ((size_t)b * RB + SEQ) * DM, (const float*)a.g_pre, MOD + (size_t)2 * 3072, CTX, gw, NGW, lane);
        }
    }
    GSYNC();

#define FILLER_CONVERT(nbusy, q) do { if (l == 0 && DEPTH > 1) { const int part_ = 2 * b + (q); const int i0_ = (I_L * part_) / 4, i1_ = (I_L * (part_ + 1)) / 4; const int nidle_ = G - (nbusy); \
        if (nidle_ > 0) { if (bid >= (nbusy)) { const __attribute__((address_space(4))) Args& a = *KARGS(); const int lane = tid_from_wave(wave_s) & 63; LAS float* scr = (LAS float*)(lds + wave_s * 16384); \
                              CONVERT_LAYER(1, (bid - (nbusy)) * 8 + wave_s, nidle_ * 8, i0_, i1_); } } \
        else { const __attribute__((address_space(4))) Args& a = *KARGS(); const int lane = tid_from_wave(wave_s) & 63; LAS float* scr = (LAS float*)(lds + wave_s * 16384); CONVERT_LAYER(1, bid * 8 + wave_s, G * 8, i0_, i1_); } } } while (0)
#define RESIDUAL_PASS(L_, B_) do { const bool upd_ = ((L_) < DEPTH - 1); const int lane_ = tid_from_wave(wave_s) & 63, gw_ = bid * 8 + wave_s; const __attribute__((address_space(4))) Args& a_ = *KARGS(); \
        const float* gp_ = (const float*)(a_.g_post + (size_t)(L_) * DM); const float* g1_ = upd_ ? (const float*)(a_.g_pre + (size_t)((L_) + 1) * DM) : gp_; \
        const float* xlat_ = ((L_) == 0 ? (const float*)a_.x : (const float*)a_.out) + (size_t)(B_) * SEQ * DM; \
        p6_pass(xlat_, (float*)a_.out + (size_t)(B_) * SEQ * DM, OUTB, upd_ ? HX + (size_t)(B_) * RB * DM : nullptr, gp_, MOD + ((size_t)(L_) * 3 + (B_)) * 3072, g1_, \
                MOD + ((size_t)(upd_ ? (L_) + 1 : (L_)) * 3 + (B_)) * 3072, SEQ, gw_, NGW, lane_); \
        if (upd_) { const float* xc_ = ((L_) == 0 ? (const float*)a_.ctx : (const float*)CTX1) + (size_t)(B_) * CTX * DM; \
            p6_pass(xc_, CTX1 + (size_t)(B_) * CTX * DM, OUTB + (size_t)SEQ * DM, HX + ((size_t)(B_) * RB + SEQ) * DM, gp_, MOD + ((size_t)(L_) * 3 + 2) * 3072, g1_, MOD + ((size_t)((L_) + 1) * 3 + 2) * 3072, \
                    CTX, gw_, NGW, lane_); } } while (0)
    for (int l = 0; l < DEPTH; ++l) {
        const bool upd = (l < DEPTH - 1);
        const int nMo = upd ? 33 : 32;
        for (int b = 0; b < NBATCH; ++b) {
            if (PH_MASK & 4) {
                PHASE_PTRS(); const unsigned char* wl = ws + WS_W + (size_t)l * W_STRIDE; (void)wl;
                pg8::OrderMN S; S.nM = 33; S.nN = NV / 256; S.nwg = S.nM * S.nN; S.G = G; S.c = bid; S.A = (const char*)(HX + (size_t)b * RB * DM); S.B = (const char*)(wl + W_IN); S.tstep = (size_t)256 * DM * 2;
                EpiInProj E{pb};
                const int ip_ = 2 * l + b - 1;
                ResidHook H{ws, ip_ >= 0 ? (ip_ >> 1) : 0, ip_ >= 0 ? (ip_ & 1) : 0, bid, G, wave_s, ip_ >= 0};
                pg8::gemm_phase(lds, DM, S, E, wave_s, H);
                if (PROBE_INPROJ2) pg8::gemm_phase(lds, DM, S, E, wave_s);
            }
            GSYNC();
            if (PH_MASK & 8) {
                PHASE_PTRS(); const unsigned char* wl = ws + WS_W + (size_t)l * W_STRIDE; (void)wl;
                pg8::OrderMN S; S.nM = 33; S.nN = 3; S.nwg = 99; S.G = G; S.c = bid; S.A = (const char*)QLAT; S.B = (const char*)(wl + W_QB); S.tstep = (size_t)256 * QLORA * 2;
                LAS float* tab = (LAS float*)(lds + 131072);
                EpiUpQ E{pb, tab};
                RstdHook<QLORA, pg8::OrderMN> H{tab, QLAT, &S, wave_s};
                pg8::gemm_phase(lds, QLORA, S, E, wave_s, H);
            }
            if (PH_MASK & 16) {
                PHASE_PTRS(); const unsigned char* wl = ws + WS_W + (size_t)l * W_STRIDE; (void)wl;
                pg8::OrderMN S; S.nM = 33; S.nN = 4; S.nwg = 132; S.G = G; S.c = (bid + G - (99 % G)) % G; S.A = (const char*)KVLAT; S.B = (const char*)(wl + W_KVB); S.tstep = (size_t)256 * KVLORA * 2;
                LAS float* tab = (LAS float*)(lds + 131072 + 8192);
                EpiUpKV E{pb, tab};
                RstdHook<KVLORA, pg8::OrderMN> H{tab, KVLAT, &S, wave_s};
                pg8::gemm_phase(lds, KVLORA, S, E, wave_s, H);
            }
            GSYNC();
            if (PH_MASK & 32) {
                PHASE_PTRS(); const unsigned char* wl = ws + WS_W + (size_t)l * W_STRIDE; (void)wl;
                const __attribute__((address_space(4))) Args& a = *KARGS();
                for (int u = bid; u < 256; u += G) {
                    const int h = u & 7, qb = u >> 3;
                    if (PROBE_MLA2) attn_unit<96, false>(lds, QB + h * 96, 768, KB + h * 96, 768, VBT + (size_t)h * 64 * RB, YB + h * 64, qb * 256, 0, RB / 64, 0, 0, NEG, 0.f, wave_s, G0 == 12345);
                    attn_unit<96, false>(lds, QB + h * 96, 768, KB + h * 96, 768, VBT + (size_t)h * 64 * RB, YB + h * 64, qb * 256, 0, RB / 64, 0, 0, NEG, 0.f, wave_s);
                }
                {
                    unsigned* wq = (unsigned*)(ws + WS_BAR + 14336) + 16 * (2 * l + b);
                    volatile LAS unsigned* slot = (volatile LAS unsigned*)(lds + LDS_MISC + 64);
                    const int n_ctx = upd ? 16 : 0, n_items = 256 + n_ctx + 264;
                    const float* cw = (const float*)(a.conv_w + (size_t)l * 3 * 512);
                    for (;;) {
                        const int tid = tid_from_wave(wave_s);
                        if (tid == 0) *slot = __hip_atomic_fetch_add(wq, 1u, __ATOMIC_RELAXED, __HIP_MEMORY_SCOPE_AGENT);
                        __syncthreads();
                        const int it = (int)*slot;
                        __syncthreads();
                        if (it >= n_items) break;
                        if (it < 256) {
                            const int h = it & 7, qb = it >> 3, q0 = qb * 256;
                            const int ka = (q0 - 128 < 0) ? 0 : q0 - 128, ke = (q0 + 384 > SEQ) ? SEQ : q0 + 384;
                            attn_unit<64, true>(lds, QA + h * 64, 512, KA + (h >> 2) * 64, 128, VAT + (size_t)(h >> 2) * 64 * RB, YA + h * 64, q0, ka, (ke - ka) / 64, SEQ, CTX / 64,
                                                a.sink[l * 8 + h] * LOG2E, 1.0f, wave_s);
                        } else if (it < 256 + n_ctx) {
                            const int u = it - 256, h = u & 7;
                            if (u < 8) attn_unit<96, false>(lds, QB + h * 96, 768, KB + h * 96, 768, VBT + (size_t)h * 64 * RB, YB + h * 64, SEQ, SEQ, CTX / 64, 0, 0, NEG, 0.f, wave_s);
                            else attn_unit<64, true>(lds, QA + h * 64, 512, KA + (h >> 2) * 64, 128, VAT + (size_t)(h >> 2) * 64 * RB, YA + h * 64, SEQ, SEQ, CTX / 64, 0, 0,
                                                     a.sink[l * 8 + h] * LOG2E, 1.0f, wave_s);
                        } else {
                            const int c0 = (it - 256 - n_ctx) * 2048;
#pragma unroll 1
                            for (int k = 0; k < 4; ++k) {
                                const int i = c0 + k * 512 + tid; if (i >= RB * 64) break;
                                const int row = i >> 6, ch = (i & 63) * 8;
                                const bool has_p = (row != 0) && (row != SEQ), has_n = (row != SEQ - 1) && (row != RB - 1);
                                const u32x4 zc = *(const u32x4*)(ZC + (size_t)row * 512 + ch);
                                const u32x4 zp = has_p ? *(const u32x4*)(ZC + (size_t)(row - 1) * 512 + ch) : (u32x4){0u, 0u, 0u, 0u};
                                const u32x4 zn = has_n ? *(const u32x4*)(ZC + (size_t)(row + 1) * 512 + ch) : (u32x4){0u, 0u, 0u, 0u};
                                const u32x4 pp = *(const u32x4*)(PC + (size_t)row * 512 + ch);
                                const f32x4 w0a = *(const f32x4*)(cw + ch), w0b = *(const f32x4*)(cw + ch + 4), w1a = *(const f32x4*)(cw + 512 + ch), w1b = *(const f32x4*)(cw + 512 + ch + 4),
                                            w2a = *(const f32x4*)(cw + 1024 + ch), w2b = *(const f32x4*)(cw + 1024 + ch + 4);
                                float y[8];
                                const unsigned zpw[4] = {zp.x, zp.y, zp.z, zp.w}, zcw[4] = {zc.x, zc.y, zc.z, zc.w}, znw[4] = {zn.x, zn.y, zn.z, zn.w}, ppw[4] = {pp.x, pp.y, pp.z, pp.w};
#pragma unroll
                                for (int e = 0; e < 4; ++e) {
                                    const float w0l = e < 2 ? w0a[2 * e] : w0b[2 * e - 4], w0h = e < 2 ? w0a[2 * e + 1] : w0b[2 * e - 3];
                                    const float w1l = e < 2 ? w1a[2 * e] : w1b[2 * e - 4], w1h = e < 2 ? w1a[2 * e + 1] : w1b[2 * e - 3];
                                    const float w2l = e < 2 ? w2a[2 * e] : w2b[2 * e - 4], w2h = e < 2 ? w2a[2 * e + 1] : w2b[2 * e - 3];
                                    y[2 * e] = bflo(ppw[e]) * (w0l * bflo(zpw[e]) + w1l * bflo(zcw[e]) + w2l * bflo(znw[e]));
                                    y[2 * e + 1] = bfhi(ppw[e]) * (w0h * bfhi(zpw[e]) + w1h * bfhi(zcw[e]) + w2h * bfhi(znw[e]));
                                }
                                *(u32x4*)(PC + (size_t)row * 512 + ch) = (u32x4){pk2(y[0], y[1]), pk2(y[2], y[3]), pk2(y[4], y[5]), pk2(y[6], y[7])};
                            }
                        }
                    }
                }
            }
            GSYNC();
            if (PH_MASK & 64) {
                PHASE_PTRS(); const unsigned char* wl = ws + WS_W + (size_t)l * W_STRIDE; (void)wl;
                pg8::OrderMerge S; S.nN = 4; S.ngrp = nMo * 4; S.G = G; S.c = bid; S.A0 = (const char*)YA; S.astride = (size_t)RB * 512 * 2; S.B0 = (const char*)(wl + W_BR); S.bstride = (size_t)1024 * 512 * 2;
                S.tstep = (size_t)256 * 512 * 2;
                if (nMo == 32) { S.nN = 8; S.ngrp = nMo * 8; S.tstepB = (size_t)128 * 512 * 2; EpiMerge E{pb, 1}; pg8::gemm_phase<1, true>(lds, 512, S, E, wave_s); }
                else { EpiMerge E{pb, 2}; pg8::gemm_phase<2, true>(lds, 512, S, E, wave_s); }
                FILLER_CONVERT(S.ngrp, 0);
                if (l == 0 && b == 0 && G > S.ngrp && bid >= S.ngrp) {
                    const __attribute__((address_space(4))) Args& a = *KARGS(); const int lane = tid_from_wave(wave_s) & 63; const int gwf = (bid - S.ngrp) * 8 + wave_s, ngwf = (G - S.ngrp) * 8;
                    hx_pass((const float*)a.x + (size_t)1 * SEQ * DM, HX + (size_t)1 * RB * DM, (const float*)a.g_pre, MOD + (size_t)1 * 3072, SEQ, gwf, ngwf, lane);
                    hx_pass((const float*)a.ctx + (size_t)1 * CTX * DM, HX + ((size_t)1 * RB + SEQ) * DM, (const float*)a.g_pre, MOD + (size_t)2 * 3072, CTX, gwf, ngwf, lane);
                }
            }
            GSYNC();
            if (PH_MASK & 128) {
                PHASE_PTRS(); const unsigned char* wl = ws + WS_W + (size_t)l * W_STRIDE; (void)wl;
                pg8::OrderMN S; S.nM = nMo; S.nN = 4; S.nwg = nMo * 4; S.G = G; S.c = bid; S.A = (const char*)MB; S.B = (const char*)(wl + W_O); S.tstep = (size_t)256 * DM * 2;
                if (nMo == 32) { S.nN = 8; S.nwg = nMo * 8; S.tstepB = (size_t)128 * DM * 2; EpiOut E{OUTB, 1}; pg8::gemm_phase<1>(lds, DM, S, E, wave_s); }
                else { EpiOut E{OUTB, 2}; pg8::gemm_phase<2>(lds, DM, S, E, wave_s); }
                FILLER_CONVERT(S.nwg, 1);
            }
            GSYNC();
        }
    }
    { PHASE_PTRS(); RESIDUAL_PASS(DEPTH - 1, NBATCH - 1); }
}

extern "C" void kernel_launch(void* const* d_in, const int* in_sizes, int n_in, void* d_out, int out_size, void* d_ws, size_t ws_size, hipStream_t stream) {
    static int grid_blocks = 0;
    if (grid_blocks == 0) {
        if (n_in != 17 || ws_size < WS_END) { fprintf(stderr, "kernel_launch: unexpected inputs (n_in %d, ws %zu < %zu)\n", n_in, ws_size, (size_t)WS_END); grid_blocks = -1; return; }
        int dev = 0, cus = 0, per_cu = 0;
        hipGetDevice(&dev);
        hipDeviceGetAttribute(&cus, hipDeviceAttributeMultiprocessorCount, dev);
        if (hipFuncSetAttribute((const void*)fwd_megakernel, hipFuncAttributeMaxDynamicSharedMemorySize, LDS_BYTES) != hipSuccess) { fprintf(stderr, "kernel_launch: hipFuncSetAttribute failed\n"); grid_blocks = -1; return; }
        if (hipOccupancyMaxActiveBlocksPerMultiprocessor(&per_cu, (const void*)fwd_megakernel, 512, LDS_BYTES) != hipSuccess || per_cu < 1) { fprintf(stderr, "kernel_launch: occupancy query says %d\n", per_cu); per_cu = 1; }
        (void)hipGetLastError();
        grid_blocks = cus * 1;
    }
    if (grid_blocks < 0) return;
    Args a{};
    a.x = (gcf_t)d_in[0]; a.c = (gcf_t)d_in[1]; a.ctx = (gcf_t)d_in[2]; a.c_ctx = (gcf_t)d_in[3]; a.w_mod = (gcf_t)d_in[4]; a.b_mod = (gcf_t)d_in[5];
    a.g_pre = (gcf_t)d_in[6]; a.g_post = (gcf_t)d_in[7]; a.w_in = (gcf_t)d_in[8]; a.sink = (gcf_t)d_in[9]; a.g_qa = (gcf_t)d_in[10]; a.w_qb = (gcf_t)d_in[11];
    a.g_kva = (gcf_t)d_in[12]; a.w_kvb = (gcf_t)d_in[13]; a.conv_w = (gcf_t)d_in[14]; a.w_branch = (gcf_t)d_in[15]; a.w_o = (gcf_t)d_in[16];
    a.out = (__attribute__((address_space(1))) float*)d_out; a.ws = (__attribute__((address_space(1))) unsigned char*)d_ws;
    void* args[] = {&a};
    hipError_t e = hipLaunchCooperativeKernel((const void*)fwd_megakernel, dim3(grid_blocks), dim3(512), args, LDS_BYTES, stream);
    if (e != hipSuccess) fprintf(stderr, "cooperative launch failed: %s (grid %d)\n", hipGetErrorString(e), grid_blocks);
}
```
